# Optimizing an MI355X kernel written in HIP

```python
import jax, jax.numpy as jnp
from jax import lax
import numpy as np

D_MODEL = 1024
BATCH = 8
SEQ = 2048
DEPTH = 2
DEC_BATCH = 128
DEC_SEQ = 4
PAST_LEN = 16384
PAGE_SIZE = 128

N_MIXERS = 2
N_A = (DEPTH + N_MIXERS - 1) // N_MIXERS
N_B = DEPTH // N_MIXERS
N_META = 16
D_RNN = D_MODEL
BLOCK_W = 256
N_BLK = D_RNN // BLOCK_W
CONV_A = 4
RG_C = 8.0
D_CONV = D_MODEL
CONV_B = 3
D_FF = ((8 * D_MODEL // 3 + 255) // 256) * 256
EPS = 1e-6

kernel_name = 'hybrid_rglru_shortconv_decode_step'


def _rmsnorm(x, w):
    xf = x.astype(jnp.float32)
    y = xf * lax.rsqrt(jnp.mean(xf * xf, axis=-1, keepdims=True) + EPS)
    return (y * w.astype(jnp.float32)).astype(x.dtype)


def _causal_dwconv(buf, u, w):
    K = w.shape[0]
    T = u.shape[1]
    full = jnp.concatenate([buf.astype(u.dtype), u], axis=1)
    y = full[:, 0:T] * w[0]
    for k in range(1, K):
        y = y + full[:, k:k + T] * w[k]
    return y, full[:, T:]


def _rglru(xc, h0, ga_w, ga_b, gx_w, gx_b, lam):
    Bn, T, _ = xc.shape
    xb = xc.reshape(Bn, T, N_BLK, BLOCK_W)
    r = jax.nn.sigmoid(jnp.einsum('bthi,hij->bthj', xb, ga_w) + ga_b).reshape(Bn, T, D_RNN)
    ig = jax.nn.sigmoid(jnp.einsum('bthi,hij->bthj', xb, gx_w) + gx_b).reshape(Bn, T, D_RNN)
    log_a = -RG_C * r.astype(jnp.float32) * jax.nn.softplus(-lam.astype(jnp.float32))
    a = jnp.exp(log_a)
    mult = jnp.sqrt(-jnp.expm1(2.0 * log_a))
    u = mult * (ig * xc).astype(jnp.float32)

    def step(h, au):
        a_t, u_t = au
        h = a_t * h + u_t
        return h, h

    hT, hs = lax.scan(step, h0.astype(jnp.float32), (jnp.swapaxes(a, 0, 1), jnp.swapaxes(u, 0, 1)))
    return jnp.swapaxes(hs, 0, 1).astype(xc.dtype), hT.astype(h0.dtype)


def _rglru_block(x, conv_buf, h0, w_in, conv_w, conv_b, ga_w, ga_b, gx_w, gx_b, lam, w_out):
    z = x @ w_in
    gate, xr = z[..., :D_RNN], z[..., D_RNN:]
    xc, new_buf = _causal_dwconv(conv_buf, xr, conv_w)
    xc = xc + conv_b
    hs, hT = _rglru(xc, h0, ga_w, ga_b, gx_w, gx_b, lam)
    y = (hs * jax.nn.gelu(gate)) @ w_out
    return y, new_buf, hT


def _shortconv_block(x, conv_buf, w_in, conv_w, w_out):
    z = x @ w_in
    bg, cg, v = z[..., :D_CONV], z[..., D_CONV:2 * D_CONV], z[..., 2 * D_CONV:]
    c, new_buf = _causal_dwconv(conv_buf, cg * v, conv_w)
    y = (bg * c) @ w_out
    return y, new_buf


def _swiglu(x, wg, wu, wd):
    return (jax.nn.silu(x @ wg) * (x @ wu)) @ wd


def setup_inputs(seed: int = 0) -> dict:
    key = jax.random.key(seed)
    ks = jax.random.split(key, 32)
    f32 = jnp.float32
    nrm = lambda k, shape, s: jax.random.normal(k, shape, f32) * s
    a_init = jax.random.uniform(ks[13], (N_A, D_RNN), f32, 0.9, 0.999)
    return {
        'x_prompt': nrm(ks[0], (BATCH, SEQ, D_MODEL), 1.0),
        'x_sample': nrm(ks[1], (DEC_BATCH, DEC_SEQ, D_MODEL), 1.0),
        'state_rglru_conv': nrm(ks[2], (N_A, DEC_BATCH, CONV_A - 1, D_RNN), 1.0),
        'state_rglru_h': nrm(ks[3], (N_A, DEC_BATCH, D_RNN), 0.5),
        'state_sconv': nrm(ks[4], (N_B, DEC_BATCH, CONV_B - 1, D_CONV), 1.0),
        'meta_tokens': nrm(ks[5], (N_META, D_MODEL), 1.0),
        'norm_mix_pre': 1.0 + nrm(ks[6], (DEPTH, D_MODEL), 0.05),
        'norm_mix_post': 1.0 + nrm(ks[7], (DEPTH, D_MODEL), 0.05),
        'norm_ffn_pre': 1.0 + nrm(ks[8], (DEPTH, D_MODEL), 0.05),
        'norm_ffn_post': 1.0 + nrm(ks[9], (DEPTH, D_MODEL), 0.05),
        'rg_w_in': nrm(ks[10], (N_A, D_MODEL, 2 * D_RNN), D_MODEL ** -0.5),
        'rg_conv_w': nrm(ks[11], (N_A, CONV_A, D_RNN), CONV_A ** -0.5),
        'rg_conv_b': nrm(ks[12], (N_A, D_RNN), 0.02),
        'rg_gate_a_w': nrm(ks[14], (N_A, N_BLK, BLOCK_W, BLOCK_W), BLOCK_W ** -0.5),
        'rg_gate_a_b': nrm(ks[15], (N_A, N_BLK, BLOCK_W), 0.02),
        'rg_gate_x_w': nrm(ks[16], (N_A, N_BLK, BLOCK_W, BLOCK_W), BLOCK_W ** -0.5),
        'rg_gate_x_b': nrm(ks[17], (N_A, N_BLK, BLOCK_W), 0.02),
        'rg_lambda': jnp.log(a_init) - jnp.log1p(-a_init),
        'rg_w_out': nrm(ks[18], (N_A, D_RNN, D_MODEL), D_RNN ** -0.5),
        'sc_w_in': nrm(ks[19], (N_B, D_MODEL, 3 * D_CONV), D_MODEL ** -0.5),
        'sc_conv_w': nrm(ks[20], (N_B, CONV_B, D_CONV), CONV_B ** -0.5),
        'sc_w_out': nrm(ks[21], (N_B, D_CONV, D_MODEL), D_CONV ** -0.5),
        'ffn_w_gate': nrm(ks[22], (DEPTH, D_MODEL, D_FF), D_MODEL ** -0.5),
        'ffn_w_up': nrm(ks[23], (DEPTH, D_MODEL, D_FF), D_MODEL ** -0.5),
        'ffn_w_down': nrm(ks[24], (DEPTH, D_FF, D_MODEL), D_FF ** -0.5),
    }


def reference(x_prompt, x_sample, state_rglru_conv, state_rglru_h, state_sconv, meta_tokens,
              norm_mix_pre, norm_mix_post, norm_ffn_pre, norm_ffn_post,
              rg_w_in, rg_conv_w, rg_conv_b, rg_gate_a_w, rg_gate_a_b, rg_gate_x_w, rg_gate_x_b,
              rg_lambda, rg_w_out, sc_w_in, sc_conv_w, sc_w_out,
              ffn_w_gate, ffn_w_up, ffn_w_down):

    def run_trunk(x, rg_conv_in, rg_h_in, sc_in):
        rg_conv_out, rg_h_out, sc_out = [], [], []
        for i in range(DEPTH):
            j = i // N_MIXERS
            hn = _rmsnorm(x, norm_mix_pre[i])
            if i % N_MIXERS == 0:
                m, cb, hT = _rglru_block(hn, rg_conv_in[j], rg_h_in[j], rg_w_in[j], rg_conv_w[j], rg_conv_b[j],
                                         rg_gate_a_w[j], rg_gate_a_b[j], rg_gate_x_w[j], rg_gate_x_b[j],
                                         rg_lambda[j], rg_w_out[j])
                rg_conv_out.append(cb)
                rg_h_out.append(hT)
            else:
                m, cb = _shortconv_block(hn, sc_in[j], sc_w_in[j], sc_conv_w[j], sc_w_out[j])
                sc_out.append(cb)
            x = x + _rmsnorm(m, norm_mix_post[i])
            f = _swiglu(_rmsnorm(x, norm_ffn_pre[i]), ffn_w_gate[i], ffn_w_up[i], ffn_w_down[i])
            x = x + _rmsnorm(f, norm_ffn_post[i])
        return x, jnp.stack(rg_conv_out), jnp.stack(rg_h_out), jnp.stack(sc_out)

    dt = x_prompt.dtype
    meta = jnp.broadcast_to(meta_tokens[None].astype(dt), (BATCH, N_META, D_MODEL))
    xp = jnp.concatenate([meta, x_prompt], axis=1)
    zc_a = jnp.zeros((N_A, BATCH, CONV_A - 1, D_RNN), dt)
    zh_a = jnp.zeros((N_A, BATCH, D_RNN), dt)
    zc_b = jnp.zeros((N_B, BATCH, CONV_B - 1, D_CONV), dt)
    yp, rg_conv_p, rg_h_p, sc_p = run_trunk(xp, zc_a, zh_a, zc_b)
    y_prompt = yp[:, N_META:]

    y_sample, rg_conv_s, rg_h_s, sc_s = run_trunk(x_sample, state_rglru_conv, state_rglru_h, state_sconv)

    return (y_prompt, y_sample, rg_conv_p, rg_h_p, sc_p, rg_conv_s, rg_h_s, sc_s)
```

```cpp
#include <hip/hip_runtime.h>
#include <hip/hip_cooperative_groups.h>
#include <cstdio>
#include <cstdint>
namespace cg = cooperative_groups;
__device__ __forceinline__ int lane_id() { return (int)__builtin_amdgcn_mbcnt_hi(~0u, __builtin_amdgcn_mbcnt_lo(~0u, 0u)); }

namespace pg8 {
#define PG8_LAS __attribute__((address_space(3)))
typedef unsigned short bf16_t;
typedef short bf16x8 __attribute__((ext_vector_type(8)));
typedef float f32x4 __attribute__((ext_vector_type(4)));
typedef unsigned u32x4 __attribute__((ext_vector_type(4)));
constexpr int BM = 256, BK = 64, HALF = 128, HTB = HALF * BK * 2  , STAGE_BYTES = 8 * HTB, NXCD = 8, WGM = 8;

__host__ __device__ __forceinline__ int lds_byte(int r, int c) { const int st = (r >> 4) * 2 + (c >> 5), rr = r & 15, cc = c & 31, ob = rr * 64 + cc * 2; return st * 1024 + (ob ^ (((ob >> 9) & 1) << 5)); }
__host__ __device__ __forceinline__ void stage_rc(int b, int& R, int& C) { const int st = b / 1024, sb = b % 1024, swz = sb ^ (((sb >> 9) & 1) << 5); R = (st >> 1) * 16 + swz / 64; C = (st & 1) * 32 + (swz % 64) / 2; }
__host__ __device__ __forceinline__ int perm32(int rho) { const int n = rho >> 4, i = rho & 15; return 8 * (i >> 2) + 4 * n + (i & 3); }

struct Unit { int pm, pn; };
struct Gemm { const bf16_t* A; const bf16_t* Bt; int M, N, K, lda, ldb, kmode, ksl; };

struct StaticOrder {
    int nM, nN, nwg, G, c, wgm;
    __host__ __device__ void init(int M, int N, int G_, int c_, int wgm_ = WGM) { nM = M / BM; nN = N / BM; nwg = nM * nN; G = G_; c = c_; wgm = wgm_; }
    __host__ __device__ bool next(int i, Unit& u) const {
        const long L = (long)i * G + c; if (L >= nwg) return false;
        int wgid = (int)L; { const int q = nwg / NXCD, r = nwg % NXCD, xcd = wgid % NXCD, off = wgid / NXCD; wgid = (xcd < r ? xcd * (q + 1) : r * (q + 1) + (xcd - r) * q) + off; }
        const int nig = wgm * nN, gid = wgid / nig, fm = gid * wgm, gsz = (nM - fm) < wgm ? (nM - fm) : wgm;
        u.pm = fm + ((wgid % nig) % gsz); u.pn = (wgid % nig) / gsz; return true;
    }
    __device__ __forceinline__ void a_ready(const Unit&) const {}
    __device__ __forceinline__ void done(const Unit&) const {}
};

__device__ __forceinline__ unsigned cvt_pk_bf16(float lo, float hi) { unsigned r; asm volatile("v_cvt_pk_bf16_f32 %0, %1, %2" : "=v"(r) : "v"(lo), "v"(hi)); return r; }

template <class Epi, class Sched, bool ALIGN_EPI = false, bool SP2 = false>
__device__ __forceinline__ void gemm_phase(PG8_LAS unsigned char* lds, const Gemm g, const Sched& S, const Epi& E, const int wave_s) {
    int tid_ = wave_s * 64 + lane_id(); asm volatile("" : "+v"(tid_));
    const int tid = tid_, wid = __builtin_amdgcn_readfirstlane(tid >> 6), lane = tid & 63, wr = wid >> 2, wc = wid & 3, fr = lane & 15, fq = lane >> 4;
    const int K = g.K, nt = K / BK;
    unsigned voffA[2], voffB[2];
#pragma unroll
    for (int i = 0; i < 2; ++i) { int R, C; stage_rc(tid * 16 + i * 8192, R, C); const int Rb = Epi::PERM ? ((R & ~31) + perm32(R & 31)) : R;
        voffA[i] = (unsigned)(R * g.lda + C) * 2u; voffB[i] = (unsigned)(Rb * g.ldb + C) * 2u; }
    const size_t kstep = (size_t)(BK * 2);
    const size_t hstepB = (size_t)HALF * g.ldb * 2, hstepA = (size_t)HALF * g.lda * 2;
    const size_t tstepB = 2 * hstepB, tstepA = 2 * hstepA;
    const unsigned ldsw = (unsigned)wid * 1024u;
    const int aoff = lds_byte(wr * 64 + fr, fq * 8), boff = lds_byte(wc * 32 + fr, fq * 8);
#define PG8_SA(b, h) (((b) * 2 + (h)) * HTB)
#define PG8_SB(b, h) ((4 + (b) * 2 + (h)) * HTB)
#define PG8_STAGE(bufoff, gbase, voff) do { _Pragma("unroll") for (int _i = 0; _i < 2; ++_i) \
        __builtin_amdgcn_global_load_lds((const unsigned*)((const char*)(gbase) + (voff)[_i]), (PG8_LAS unsigned*)(lds + (bufoff) + ldsw + _i * 8192), 16, 0, 0); } while (0)
#define PG8_LDA(dst, b, h) do { _Pragma("unroll") for (int m = 0; m < 4; ++m) _Pragma("unroll") for (int k = 0; k < 2; ++k) dst[m][k] = *(const PG8_LAS bf16x8*)(lds + PG8_SA(b, h) + aoff + m * 2048 + k * 1024); } while (0)
#define PG8_LDB(dst, b, h) do { _Pragma("unroll") for (int n = 0; n < 2; ++n) _Pragma("unroll") for (int k = 0; k < 2; ++k) dst[n][k] = *(const PG8_LAS bf16x8*)(lds + PG8_SB(b, h) + boff + n * 2048 + k * 1024); } while (0)
#define PG8_MMA(ai, bj, At, Bt) do { __builtin_amdgcn_s_setprio(1); _Pragma("unroll") for (int m = 0; m < 4; ++m) _Pragma("unroll") for (int n = 0; n < 2; ++n) _Pragma("unroll") for (int k = 0; k < 2; ++k) \
        acc[ai][bj][m][n] = __builtin_amdgcn_mfma_f32_16x16x32_bf16(Bt[n][k], At[m][k], acc[ai][bj][m][n], 0, 0, 0); __builtin_amdgcn_s_setprio(0); } while (0)
#define PG8_WAIT_V(n) asm volatile("s_waitcnt vmcnt(" #n ")" ::: "memory")
#define PG8_WAIT_L(n) asm volatile("s_waitcnt lgkmcnt(" #n ")" ::: "memory")
#define PG8_BAR __builtin_amdgcn_s_barrier()
#define PG8_SCHED __builtin_amdgcn_sched_barrier(0)
    Unit cur, nxt; int ui = 0;
    if (!S.next(0, cur)) return;
    f32x4 acc[2][2][4][2];
#pragma unroll
    for (int a = 0; a < 2; ++a)
#pragma unroll
        for (int b = 0; b < 2; ++b)
#pragma unroll
            for (int m = 0; m < 4; ++m)
#pragma unroll
                for (int n = 0; n < 2; ++n) acc[a][b][m][n] = (f32x4){0.f, 0.f, 0.f, 0.f};
    bf16x8 At[4][2], B0[2][2], B1[2][2];
    const char* cA = (const char*)g.A + (size_t)cur.pm * tstepA + (g.kmode == 1 ? (size_t)(cur.pn >> 1) * 512 : g.kmode == 2 ? (size_t)(cur.pn % g.ksl) * (size_t)(K * 2) : (size_t)0); const char* cB = (const char*)g.Bt + (g.kmode == 2 ? (size_t)(cur.pn / g.ksl) * tstepB + (size_t)(cur.pn % g.ksl) * (size_t)(K * 2) : (size_t)cur.pn * tstepB);
    S.a_ready(cur);
    if constexpr (SP2) {
        PG8_STAGE(PG8_SB(0, 0), cB, voffB); PG8_STAGE(PG8_SB(0, 1), cB + hstepB, voffB); PG8_STAGE(PG8_SA(0, 0), cA, voffA); PG8_STAGE(PG8_SA(0, 1), cA + hstepA, voffA);
        if (wr == 1) PG8_BAR;
        PG8_WAIT_V(2); PG8_BAR;
        PG8_STAGE(PG8_SB(1, 0), cB + kstep, voffB); PG8_STAGE(PG8_SA(1, 0), cA + kstep, voffA); PG8_STAGE(PG8_SB(1, 1), cB + hstepB + kstep, voffB);
        PG8_WAIT_V(6); PG8_BAR;
    } else {
        PG8_STAGE(PG8_SB(0, 0), cB, voffB); PG8_STAGE(PG8_SA(0, 0), cA, voffA); PG8_STAGE(PG8_SB(0, 1), cB + hstepB, voffB); PG8_STAGE(PG8_SA(0, 1), cA + hstepA, voffA);
        if (wr == 1) PG8_BAR;
        PG8_WAIT_V(4); PG8_BAR;
        PG8_STAGE(PG8_SB(1, 0), cB + kstep, voffB); PG8_STAGE(PG8_SA(1, 0), cA + kstep, voffA); PG8_STAGE(PG8_SB(1, 1), cB + hstepB + kstep, voffB);
        PG8_WAIT_V(6); PG8_BAR;
    }
    for (;;) {
        const bool has_next = S.next(ui + 1, nxt);
        const char* nA = has_next ? (const char*)g.A + (size_t)nxt.pm * tstepA + (g.kmode == 1 ? (size_t)(nxt.pn >> 1) * 512 : g.kmode == 2 ? (size_t)(nxt.pn % g.ksl) * (size_t)(K * 2) : (size_t)0) : cA; const char* nB = has_next ? (const char*)g.Bt + (g.kmode == 2 ? (size_t)(nxt.pn / g.ksl) * tstepB + (size_t)(nxt.pn % g.ksl) * (size_t)(K * 2) : (size_t)nxt.pn * tstepB) : cB;
        for (int t = 0; t < nt; t += 2) {
            const bool last = (t == nt - 2);
            const char* a1 = cA + (size_t)(t + 1) * kstep;
            const char* a2 = last ? nA : cA + (size_t)(t + 2) * kstep; const char* b2 = last ? nB : cB + (size_t)(t + 2) * kstep;
            const char* a3 = a2 + kstep; const char* b3 = b2 + kstep;
            if (last && has_next) S.a_ready(nxt);
            if constexpr (SP2) {
            PG8_LDB(B0, 0, 0); PG8_LDB(B1, 0, 1); PG8_SCHED; PG8_LDA(At, 0, 0); PG8_STAGE(PG8_SA(1, 1), a1 + hstepA, voffA);
            PG8_WAIT_V(8); PG8_WAIT_L(0); PG8_BAR; PG8_MMA(0, 0, At, B0); PG8_MMA(0, 1, At, B1); PG8_BAR; PG8_SCHED;
            PG8_LDA(At, 0, 1); PG8_STAGE(PG8_SB(0, 0), b2, voffB); PG8_STAGE(PG8_SB(0, 1), b2 + hstepB, voffB); PG8_STAGE(PG8_SA(0, 0), a2, voffA);
            PG8_WAIT_V(8); PG8_WAIT_L(0); PG8_BAR; PG8_MMA(1, 0, At, B0); PG8_MMA(1, 1, At, B1); PG8_BAR; PG8_SCHED;
            PG8_LDB(B0, 1, 0); PG8_LDB(B1, 1, 1); PG8_SCHED; PG8_LDA(At, 1, 0); PG8_STAGE(PG8_SA(0, 1), a2 + hstepA, voffA);
            PG8_WAIT_V(8); PG8_WAIT_L(0); PG8_BAR; PG8_MMA(0, 0, At, B0); PG8_MMA(0, 1, At, B1); PG8_BAR; PG8_SCHED;
            PG8_LDA(At, 1, 1); PG8_STAGE(PG8_SB(1, 0), b3, voffB); PG8_STAGE(PG8_SB(1, 1), b3 + hstepB, voffB); PG8_STAGE(PG8_SA(1, 0), a3, voffA);
            PG8_WAIT_V(8); PG8_WAIT_L(0); PG8_BAR; PG8_MMA(1, 0, At, B0); PG8_MMA(1, 1, At, B1); PG8_BAR; PG8_SCHED;
            } else {
            PG8_LDB(B0, 0, 0); PG8_SCHED; PG8_LDA(At, 0, 0); PG8_STAGE(PG8_SA(1, 1), a1 + hstepA, voffA);
            PG8_WAIT_L(8); PG8_BAR; PG8_WAIT_L(0); PG8_MMA(0, 0, At, B0); PG8_BAR; PG8_SCHED;
            PG8_LDB(B1, 0, 1); PG8_STAGE(PG8_SB(0, 0), b2, voffB);
            PG8_BAR; PG8_WAIT_L(0); PG8_MMA(0, 1, At, B1); PG8_BAR;
            PG8_LDA(At, 0, 1); PG8_STAGE(PG8_SA(0, 0), a2, voffA);
            PG8_BAR; PG8_WAIT_L(0); PG8_MMA(1, 0, At, B0); PG8_BAR; PG8_SCHED;
            PG8_STAGE(PG8_SB(0, 1), b2 + hstepB, voffB);
            PG8_WAIT_V(6); PG8_BAR; PG8_MMA(1, 1, At, B1); PG8_BAR;
            PG8_LDB(B0, 1, 0); PG8_SCHED; PG8_LDA(At, 1, 0); PG8_STAGE(PG8_SA(0, 1), a2 + hstepA, voffA);
            PG8_WAIT_L(8); PG8_BAR; PG8_WAIT_L(0); PG8_MMA(0, 0, At, B0); PG8_BAR; PG8_SCHED;
            PG8_LDB(B1, 1, 1); PG8_STAGE(PG8_SB(1, 0), b3, voffB);
            PG8_BAR; PG8_WAIT_L(0); PG8_MMA(0, 1, At, B1); PG8_BAR;
            PG8_LDA(At, 1, 1); PG8_STAGE(PG8_SA(1, 0), a3, voffA);
            PG8_BAR; PG8_WAIT_L(0); PG8_MMA(1, 0, At, B0); PG8_BAR; PG8_SCHED;
            PG8_STAGE(PG8_SB(1, 1), b3 + hstepB, voffB);
            PG8_WAIT_V(6); PG8_BAR; PG8_MMA(1, 1, At, B1); PG8_BAR;
            }
        }
        if constexpr (ALIGN_EPI) { if (wr == 0) PG8_BAR; }
        if constexpr (!Epi::AFTER_DRAIN) { E(acc, cur, wr, wc, fr, fq); S.done(cur); }
        if (!has_next) break;
#pragma unroll
        for (int a = 0; a < 2; ++a)
#pragma unroll
            for (int b = 0; b < 2; ++b)
#pragma unroll
                for (int m = 0; m < 4; ++m)
#pragma unroll
                    for (int n = 0; n < 2; ++n) acc[a][b][m][n] = (f32x4){0.f, 0.f, 0.f, 0.f};
        cur = nxt; cA = nA; cB = nB; ++ui;
        if constexpr (ALIGN_EPI) { if (wr == 1) PG8_BAR; }
    }
    PG8_WAIT_V(0);
    if constexpr (!ALIGN_EPI) { if (wr == 0) PG8_BAR; }
    PG8_BAR;
    if constexpr (Epi::AFTER_DRAIN) { E.fused(acc, cur, wr, wc, fr, fq, lds, wid, lane); S.done(cur); }
#undef PG8_SA
#undef PG8_SB
#undef PG8_STAGE
#undef PG8_LDA
#undef PG8_LDB
#undef PG8_MMA
#undef PG8_WAIT_V
#undef PG8_WAIT_L
#undef PG8_BAR
#undef PG8_SCHED
}
}


constexpr int D = 1024, DFF = 2816, TP = 2064  , NPR = 8 * TP  , NSM = 512, MR = NPR + NSM  , MP = 17152  ;
constexpr float EPS = 1e-6f;
constexpr int MAINR = 16384  , XROWS = MP - MAINR  ;
constexpr size_t O_YP = 0, O_YS = 16777216, O_RCP = 17301504, O_RHP = 17326080, O_SCP = 17334272, O_RCS = 17350656, O_RHS = 17743872, O_SCS = 17874944;
constexpr size_t MiB = 1u << 20;
constexpr size_t WS_WIN0 = 1 * MiB, WS_WG = 5 * MiB, WS_WOUT0 = 6 * MiB, WS_WSCIN = 8 * MiB, WS_WSCOUT = 14 * MiB, WS_WGU = 16 * MiB, WS_WD = 38 * MiB;
constexpr size_t WS_XMETA = 49 * MiB, WS_STATS = 50 * MiB, WS_AGG = 52 * MiB, WS_HN = 56 * MiB, WS_Y = 90 * MiB, WS_R1 = 124 * MiB, WS_R1B = 158 * MiB, WS_Y2 = 218 * MiB, WS_END = 252 * MiB;
static_assert(WS_HN + (size_t)MP * D * 2 <= WS_Y && WS_Y + (size_t)MP * D * 2 <= WS_R1 && WS_R1 + (size_t)MP * D * 2 <= WS_R1B && WS_R1 + (size_t)MP * DFF * 2 <= WS_Y2 && WS_Y2 + (size_t)MP * D * 2 <= WS_END, "ws map");
constexpr int LDS_BYTES = 135168;

#define GAS __attribute__((address_space(1)))
#define LAS __attribute__((address_space(3)))
typedef unsigned short bf16;
typedef unsigned v4u __attribute__((ext_vector_type(4)));
typedef unsigned v2u __attribute__((ext_vector_type(2)));
typedef float f32x4 __attribute__((ext_vector_type(4)));
typedef float f32x16 __attribute__((ext_vector_type(16)));
typedef short bf16x8 __attribute__((ext_vector_type(8)));

struct Args { const float* in[25]; float* out; unsigned char* ws; };

__device__ __forceinline__ unsigned pk2(float lo, float hi) { return pg8::cvt_pk_bf16(lo, hi); }
__device__ __forceinline__ float bflo(unsigned w) { return __uint_as_float(w << 16); }
__device__ __forceinline__ float bfhi(unsigned w) { return __uint_as_float(w & 0xffff0000u); }
__device__ __forceinline__ float sigmoidf_(float x) { return __builtin_amdgcn_rcpf(1.0f + __expf(-x)); }
__device__ __forceinline__ float gelu_tanh(float x) { const float z = 1.5957691216f * (x + 0.044715f * x * x * x); return x * sigmoidf_(z); }
__device__ __forceinline__ float silu_(float x) { return x * sigmoidf_(x); }
__device__ __forceinline__ float wave_sum(float v) {
#pragma unroll
    for (int o = 1; o < 64; o <<= 1) v += __shfl_xor(v, o);
    return v;
}
#define LDS_WAIT() asm volatile("s_waitcnt lgkmcnt(0)" ::: "memory")

__device__ __forceinline__ void st16_wt(bf16* p, v4u w) { asm volatile("global_store_dwordx4 %0, %1, off sc0 sc1\n\ts_nop 1" :: "v"((GAS v4u*)p), "v"(w) : "memory"); }
__device__ __forceinline__ void st16f_wt(GAS f32x4* p, f32x4 w) { asm volatile("global_store_dwordx4 %0, %1, off sc0 sc1\n\ts_nop 1" :: "v"(p), "v"(w) : "memory"); }
__device__ __forceinline__ void st8_wt(GAS v2u* p, v2u w) { asm volatile("global_store_dwordx2 %0, %1, off sc0 sc1\n\ts_nop 1" :: "v"(p), "v"(w) : "memory"); }
__device__ __forceinline__ void st4_wt(float* p, float v) { asm volatile("global_store_dword %0, %1, off sc0 sc1\n\ts_nop 1" :: "v"((GAS float*)p), "v"(v) : "memory"); }
struct EpiGen {
    static constexpr bool PERM = true, AFTER_DRAIN = false;
    int mode;
    bf16* O0; bf16* O1; float* stats;
    const bf16* XC; const float* pa; const float* pb; const float* pl;
    int ksl;
    __device__ __forceinline__ void operator()(const pg8::f32x4 (&acc)[2][2][4][2], const pg8::Unit& u, int wr, int wc, int fr, int fq) const {
        const int row0 = u.pm * 256 + wr * 64 + fr;
        if (mode == 5) {
            const int ks = u.pn % ksl, pnr = u.pn / ksl;
            bf16* base = O1 + ((size_t)ks * XROWS + (size_t)(row0 - MAINR)) * D + pnr * 256 + wc * 32 + 8 * fq;
#pragma unroll
            for (int ai = 0; ai < 2; ++ai)
#pragma unroll
                for (int m = 0; m < 4; ++m) {
                    bf16* rowp = base + (size_t)(ai * 128 + m * 16) * D;
#pragma unroll
                    for (int bj = 0; bj < 2; ++bj) { const pg8::f32x4 v0 = acc[ai][bj][m][0], v1 = acc[ai][bj][m][1];
                        v4u w; w.x = pk2(v0[0], v0[1]); w.y = pk2(v0[2], v0[3]); w.z = pk2(v1[0], v1[1]); w.w = pk2(v1[2], v1[3]);
                        st16_wt(rowp + bj * 128, w); }
                }
        } else if (mode == 4) {
            const int c0 = 256 * (u.pn >> 1) + 128 * (u.pn & 1) + wc * 32 + 8 * fq;
            float bA[8], bX[8], sp8[8];
            { const f32x4 a0 = *(const GAS f32x4*)(pa + c0), a1 = *(const GAS f32x4*)(pa + c0 + 4), b0 = *(const GAS f32x4*)(pb + c0), b1 = *(const GAS f32x4*)(pb + c0 + 4), l0 = *(const GAS f32x4*)(pl + c0), l1 = *(const GAS f32x4*)(pl + c0 + 4);
#pragma unroll
                for (int i = 0; i < 4; ++i) { bA[i] = a0[i]; bA[4 + i] = a1[i]; bX[i] = b0[i]; bX[4 + i] = b1[i]; sp8[i] = -8.0f * log1pf(__expf(-l0[i])); sp8[4 + i] = -8.0f * log1pf(__expf(-l1[i])); } }
#pragma unroll
            for (int ai = 0; ai < 2; ++ai)
#pragma unroll
                for (int m = 0; m < 4; ++m) {
                    const size_t off = (size_t)(row0 + ai * 128 + m * 16) * D + c0;
                    const v4u xq = *(const GAS v4u*)(XC + off);
                    float xc[8] = {bflo(xq.x), bfhi(xq.x), bflo(xq.y), bfhi(xq.y), bflo(xq.z), bfhi(xq.z), bflo(xq.w), bfhi(xq.w)};
                    float om[8], uu[8];
#pragma unroll
                    for (int n = 0; n < 2; ++n)
#pragma unroll
                        for (int i = 0; i < 4; ++i) { const int e = 4 * n + i;
                            const float r = sigmoidf_(acc[ai][0][m][n][i] + bA[e]), ig = sigmoidf_(acc[ai][1][m][n][i] + bX[e]);
                            const float av = __expf(sp8[e] * r), o1 = 1.0f - av;
                            om[e] = o1; uu[e] = __builtin_amdgcn_sqrtf(fmaxf(o1 * (1.0f + av), 0.f)) * ig * xc[e]; }
                    v4u w; w.x = pk2(om[0], om[1]); w.y = pk2(om[2], om[3]); w.z = pk2(om[4], om[5]); w.w = pk2(om[6], om[7]);
                    st16_wt(O0 + off, w);
                    w.x = pk2(uu[0], uu[1]); w.y = pk2(uu[2], uu[3]); w.z = pk2(uu[4], uu[5]); w.w = pk2(uu[6], uu[7]);
                    st16_wt(O1 + off, w);
                }
        } else if (mode == 3) {
            bf16* base = O0 + (size_t)row0 * D + u.pn * 256 + wc * 32 + 8 * fq;
#pragma unroll
            for (int ai = 0; ai < 2; ++ai)
#pragma unroll
                for (int m = 0; m < 4; ++m) {
                    bf16* rowp = base + (size_t)(ai * 128 + m * 16) * D; float ss = 0.f;
#pragma unroll
                    for (int bj = 0; bj < 2; ++bj) { const pg8::f32x4 v0 = acc[ai][bj][m][0], v1 = acc[ai][bj][m][1];
                        ss += (v0[0] * v0[0] + v0[1] * v0[1]) + (v0[2] * v0[2] + v0[3] * v0[3]) + (v1[0] * v1[0] + v1[1] * v1[1]) + (v1[2] * v1[2] + v1[3] * v1[3]);
                        v4u w; w.x = pk2(v0[0], v0[1]); w.y = pk2(v0[2], v0[3]); w.z = pk2(v1[0], v1[1]); w.w = pk2(v1[2], v1[3]);
                        st16_wt(rowp + bj * 128, w); }
                    ss += __shfl_xor(ss, 16); ss += __shfl_xor(ss, 32);
                    if (fq == 0) st4_wt(stats + (size_t)(row0 + ai * 128 + m * 16) * 16 + u.pn * 4 + wc, ss);
                }
        } else if (mode == 1 || (mode == 2 && u.pn >= 4)) {
            const int ldc = (mode == 1) ? DFF : D; const int q = (mode == 1) ? u.pn : (u.pn - 4);
            bf16* base = (mode == 1 ? O0 : O1) + (size_t)row0 * ldc + q * 128 + wc * 32 + 8 * fq;
#pragma unroll
            for (int ai = 0; ai < 2; ++ai)
#pragma unroll
                for (int m = 0; m < 4; ++m) {
                    pg8::f32x4 g0 = acc[ai][0][m][0], g1 = acc[ai][0][m][1]; const pg8::f32x4 u0 = acc[ai][1][m][0], u1 = acc[ai][1][m][1];
                    if (mode == 1) {
#pragma unroll
                        for (int i = 0; i < 4; ++i) { g0[i] = silu_(g0[i]); g1[i] = silu_(g1[i]); } }
                    g0 = g0 * u0; g1 = g1 * u1;
                    v4u w; w.x = pk2(g0[0], g0[1]); w.y = pk2(g0[2], g0[3]); w.z = pk2(g1[0], g1[1]); w.w = pk2(g1[2], g1[3]);
                    st16_wt(base + (size_t)(ai * 128 + m * 16) * ldc, w);
                }
        } else {
            const bool act = (mode == 0 && u.pn < 4);
            bf16* base = (u.pn < 4 ? O0 : O1) + (size_t)row0 * D + (u.pn & 3) * 256 + wc * 32 + 8 * fq;
#pragma unroll
            for (int ai = 0; ai < 2; ++ai)
#pragma unroll
                for (int m = 0; m < 4; ++m) {
                    bf16* rowp = base + (size_t)(ai * 128 + m * 16) * D;
#pragma unroll
                    for (int bj = 0; bj < 2; ++bj) { pg8::f32x4 v0 = acc[ai][bj][m][0], v1 = acc[ai][bj][m][1];
                        if (act) {
#pragma unroll
                            for (int i = 0; i < 4; ++i) { v0[i] = gelu_tanh(v0[i]); v1[i] = gelu_tanh(v1[i]); } }
                        v4u w; w.x = pk2(v0[0], v0[1]); w.y = pk2(v0[2], v0[3]); w.z = pk2(v1[0], v1[1]); w.w = pk2(v1[2], v1[3]);
                        st16_wt(rowp + bj * 128, w); }
                }
        }
    }
};

__device__ __forceinline__ float* xrow(const Args& a, int r) {
    if (r < NPR) { const int b = r / TP, t = r - b * TP;
        if (t < 16) return (float*)(a.ws + WS_XMETA) + (size_t)(b * 16 + t) * D;
        return a.out + O_YP + (size_t)(b * 2048 + (t - 16)) * D; }
    return a.out + O_YS + (size_t)(r - NPR) * D;
}
__device__ __forceinline__ const float* xsrc(const Args& a, int r) {
    if (r < NPR) { const int b = r / TP, t = r - b * TP;
        if (t < 16) return a.in[5] + (size_t)t * D;
        return a.in[0] + (size_t)(b * 2048 + (t - 16)) * D; }
    return a.in[1] + (size_t)(r - NPR) * D;
}

__device__ __forceinline__ int rowmap(int kind, int n) {
    if (kind == 0) return n;
    if (kind == 1) return 256 * (n >> 7) + (n & 127);
    if (kind == 2) return 256 * (n >> 7) + 128 + (n & 127);
    if (n < 1024) return n;
    if (n < 2048) { const int c = n - 1024; return 1024 + 256 * (c >> 7) + (c & 127); }
    { const int c = n - 2048; return 1024 + 256 * (c >> 7) + 128 + (c & 127); }
}
__device__ __forceinline__ void transpose_item(const float* W, int K, int N, bf16* WT, int kind, LAS float* scr, int item, int lane) {
    const int nblk = N / 32, kb = item / nblk, nb = item - kb * nblk, k0 = 64 * kb, n0 = 32 * nb;
    const GAS float* Wg = (const GAS float*)W;
#pragma unroll 8
    for (int i = 0; i < 32; ++i) { const int kk = 2 * i + (lane >> 5); scr[kk * 33 + (lane & 31)] = Wg[(size_t)(k0 + kk) * N + n0 + (lane & 31)]; }
    LDS_WAIT(); asm volatile("" ::: "memory");
    const int c = lane & 7; const int rb = rowmap(kind, n0);
#pragma unroll
    for (int j = 0; j < 4; ++j) { const int n = (lane >> 3) + 8 * j; const LAS float* s = scr + (8 * c) * 33 + n;
        v4u o; o.x = pk2(s[0 * 33], s[1 * 33]); o.y = pk2(s[2 * 33], s[3 * 33]); o.z = pk2(s[4 * 33], s[5 * 33]); o.w = pk2(s[6 * 33], s[7 * 33]);
        *(GAS v4u*)(WT + (size_t)(rb + n) * K + k0 + 8 * c) = o; }
    LDS_WAIT(); asm volatile("" ::: "memory");
}
constexpr int I_IN0 = 16 * 64, I_G = 4 * 8, I_O = 16 * 32, I_SC = 16 * 96, I_GU = 16 * 88, I_DN = 44 * 32;
constexpr int NITEMS = I_IN0 + 8 * I_G + 2 * I_O + I_SC + 4 * I_GU + 2 * I_DN, NITEMS_A = I_IN0 + 8 * I_G;
__device__ __forceinline__ void p0_item(const Args& a, LAS float* scr, int it, int lane) {
    unsigned char* ws = a.ws;
    do {
        int r = it;
        if (r < I_IN0) { transpose_item(a.in[10], 1024, 2048, (bf16*)(ws + WS_WIN0), 0, scr, r, lane); continue; } r -= I_IN0;
        if (r < 8 * I_G) { const int m = r / I_G, h = m & 3, gx = m >> 2;
            transpose_item(a.in[gx ? 15 : 13] + (size_t)h * 65536, 256, 256, (bf16*)(ws + WS_WG) + (size_t)h * 131072, gx ? 2 : 1, scr, r - m * I_G, lane); continue; } r -= 8 * I_G;
        if (r < I_O) { transpose_item(a.in[18], 1024, 1024, (bf16*)(ws + WS_WOUT0), 0, scr, r, lane); continue; } r -= I_O;
        if (r < I_SC) { transpose_item(a.in[19], 1024, 3072, (bf16*)(ws + WS_WSCIN), 3, scr, r, lane); continue; } r -= I_SC;
        if (r < I_O) { transpose_item(a.in[21], 1024, 1024, (bf16*)(ws + WS_WSCOUT), 0, scr, r, lane); continue; } r -= I_O;
        if (r < 4 * I_GU) { const int m = r / I_GU, l = m & 1, up = m >> 1;
            transpose_item(a.in[up ? 23 : 22] + (size_t)l * 1024 * DFF, 1024, DFF, (bf16*)(ws + WS_WGU) + (size_t)l * 5632 * 1024, up ? 2 : 1, scr, r - m * I_GU, lane); continue; } r -= 4 * I_GU;
        { const int l = r / I_DN; transpose_item(a.in[24] + (size_t)l * DFF * 1024, DFF, 1024, (bf16*)(ws + WS_WD) + (size_t)l * 1024 * DFF, 0, scr, r - l * I_DN, lane); }
    } while (0);
}
__device__ __forceinline__ void p0_phase(const Args& a, LAS unsigned char* lds, int wave, int lane) {
    { int t_ = lane_id(); asm volatile("" : "+v"(t_)); lane = t_; }
    LAS float* scr = (LAS float*)(lds + wave * 16384);
    const int gw = blockIdx.x * 8 + wave, NGW = gridDim.x * 8;
    unsigned char* ws = a.ws;
    for (int it = gw; it < NITEMS_A; it += NGW) p0_item(a, scr, it, lane);
    const GAS f32x4* wq = (const GAS f32x4*)a.in[6] + lane;
    f32x4 wpre[4];
#pragma unroll
    for (int j = 0; j < 4; ++j) wpre[j] = wq[64 * j];
    bf16* HN = (bf16*)(ws + WS_HN);
    for (int r0 = gw; r0 < MR; r0 += 2 * NGW) {
        f32x4 v[2][4]; float ss[2] = {0.f, 0.f};
#pragma unroll
        for (int u = 0; u < 2; ++u) { const int r = (r0 + u * NGW < MR) ? r0 + u * NGW : r0; const GAS f32x4* xs = (const GAS f32x4*)xsrc(a, r) + lane;
#pragma unroll
            for (int j = 0; j < 4; ++j) v[u][j] = xs[64 * j]; }
#pragma unroll
        for (int u = 0; u < 2; ++u) {
#pragma unroll
            for (int j = 0; j < 4; ++j) ss[u] += (v[u][j].x * v[u][j].x + v[u][j].y * v[u][j].y) + (v[u][j].z * v[u][j].z + v[u][j].w * v[u][j].w);
            const float rs = rsqrtf(wave_sum(ss[u]) * (1.0f / D) + EPS);
            const int r = r0 + u * NGW;
            if (r < MR) { GAS v2u* o8 = (GAS v2u*)(HN + (size_t)r * D) + lane;
#pragma unroll
                for (int j = 0; j < 4; ++j) { const f32x4 h = v[u][j] * rs * wpre[j]; v2u o; o.x = pk2(h.x, h.y); o.y = pk2(h.z, h.w); o8[64 * j] = o; } }
        }
    }
}

constexpr int CW_CNT = 4096, CW_BANK = 8192, CW_Q = CW_CNT + 14 * CW_BANK, CTL_WORDS = CW_Q + 8 * 64;
__device__ __forceinline__ unsigned ld_rlx(unsigned* p) { return __hip_atomic_load(p, __ATOMIC_RELAXED, __HIP_MEMORY_SCOPE_AGENT); }
struct PubOrder : pg8::StaticOrder {
    unsigned* cnt;
    __device__ __forceinline__ void done(const pg8::Unit& u) const {
        asm volatile("s_waitcnt vmcnt(0)" ::: "memory");
        if (lane_id() == 0) __hip_atomic_fetch_add(cnt + 64 * u.pm, 1u, __ATOMIC_RELAXED, __HIP_MEMORY_SCOPE_AGENT);
    }
};
struct ExtraOrder : PubOrder {
    int ksl;
    __device__ __forceinline__ bool next(int i, pg8::Unit& u) const { const int L = i * G + c; if (L >= 12 * ksl) return false; u.pm = 64 + L / (4 * ksl); u.pn = L % (4 * ksl); return true; }
};
struct CountedOrder : pg8::StaticOrder {
    unsigned* gready; unsigned gneed;
    unsigned* ready; unsigned need, need66; int wv;
    unsigned* gcnt;
    unsigned* cnt;
    __device__ __forceinline__ void a_ready(const pg8::Unit& u) const {
        if (wv == 0) {
            const unsigned nd = (u.pm < 66) ? need : need66;
            unsigned sp = 0;
            while ((unsigned)__builtin_amdgcn_readfirstlane(__hip_atomic_load(ready + 64 * u.pm, __ATOMIC_RELAXED, __HIP_MEMORY_SCOPE_AGENT)) < nd) { __builtin_amdgcn_s_sleep(2); if (++sp > (1u << 18)) break; }
            if (gready) { while ((unsigned)__builtin_amdgcn_readfirstlane(__hip_atomic_load(gready, __ATOMIC_RELAXED, __HIP_MEMORY_SCOPE_AGENT)) < gneed) { __builtin_amdgcn_s_sleep(2); if (++sp > (1u << 18)) break; } }
            __builtin_amdgcn_fence(__ATOMIC_ACQUIRE, "agent");
            asm volatile("s_waitcnt vmcnt(0)" ::: "memory");
        }
        asm volatile("" ::: "memory"); __builtin_amdgcn_s_barrier(); asm volatile("" ::: "memory");
    }
    __device__ __forceinline__ void done(const pg8::Unit& u) const {
        if (cnt) { asm volatile("s_waitcnt vmcnt(0)" ::: "memory");
            if (lane_id() == 0) { __hip_atomic_fetch_add(cnt + 64 * u.pm, 1u, __ATOMIC_RELAXED, __HIP_MEMORY_SCOPE_AGENT); if (gcnt) __hip_atomic_fetch_add(gcnt, 1u, __ATOMIC_RELAXED, __HIP_MEMORY_SCOPE_AGENT); } }
    }
};
struct ExtraOrderC : CountedOrder {
    int ksl;
    __device__ __forceinline__ bool next(int i, pg8::Unit& u) const { const int L = i * G + c; if (L >= 12 * ksl) return false; u.pm = 64 + L / (4 * ksl); u.pn = L % (4 * ksl); return true; }
};
#define TAIL_BEGIN(BANK, NCHUNKS, NEED, PLO_EXPR, PHI_EXPR) \
    for (;;) { __syncthreads(); \
        if (wave == 0 && lane_id() == 0) { const unsigned c_ = __hip_atomic_fetch_add(ctl + CW_Q + 64 * (BANK), 1u, __ATOMIC_RELAXED, __HIP_MEMORY_SCOPE_AGENT); \
            if (c_ < (unsigned)(NCHUNKS)) { const int chunk = (int)c_; const int plo_ = (PLO_EXPR), phi_ = (PHI_EXPR); \
                for (int p_ = plo_; p_ <= phi_; ++p_) { unsigned sp_ = 0; while (ld_rlx(ctl + CW_CNT + (BANK) * CW_BANK + 64 * p_) < (unsigned)(NEED)) { __builtin_amdgcn_s_sleep(2); if (++sp_ > (1u << 18)) break; } } \
                __builtin_amdgcn_fence(__ATOMIC_ACQUIRE, "agent"); asm volatile("s_waitcnt vmcnt(0)" ::: "memory"); } \
            *bc = c_; } \
        __syncthreads(); \
        const unsigned cu_ = *bc; if (cu_ >= (unsigned)(NCHUNKS)) break; const int chunk = (int)cu_;
#define TAIL_END }
#define TAIL_BEGIN_PUB(BANK, PUBBANK, NCHUNKS, NEED, PLO_EXPR, PHI_EXPR) \
    int prevp_ = -1; \
    for (;;) { __syncthreads(); \
        if (wave == 0 && lane_id() == 0) { \
            if (prevp_ >= 0) { __hip_atomic_fetch_add(ctl + CW_CNT + (PUBBANK) * CW_BANK + 64 * prevp_, 1u, __ATOMIC_RELAXED, __HIP_MEMORY_SCOPE_AGENT); \
                               __hip_atomic_fetch_add(ctl + CW_CNT + (PUBBANK) * CW_BANK + 64 * 100, 1u, __ATOMIC_RELAXED, __HIP_MEMORY_SCOPE_AGENT); } \
            const unsigned c_ = __hip_atomic_fetch_add(ctl + CW_Q + 64 * (BANK), 1u, __ATOMIC_RELAXED, __HIP_MEMORY_SCOPE_AGENT); \
            if (c_ < (unsigned)(NCHUNKS)) { const int chunk = (int)c_; const int plo_ = (PLO_EXPR), phi_ = (PHI_EXPR); \
                for (int p_ = plo_; p_ <= phi_; ++p_) { unsigned sp_ = 0; while (ld_rlx(ctl + CW_CNT + (BANK) * CW_BANK + 64 * p_) < (unsigned)(NEED)) { __builtin_amdgcn_s_sleep(2); if (++sp_ > (1u << 18)) break; } } \
                __builtin_amdgcn_fence(__ATOMIC_ACQUIRE, "agent"); asm volatile("s_waitcnt vmcnt(0)" ::: "memory"); } \
            *bc = c_; } \
        __syncthreads(); \
        const unsigned cu_ = *bc; if (cu_ >= (unsigned)(NCHUNKS)) break; const int chunk = (int)cu_; prevp_ = (PHI_EXPR);

__device__ __forceinline__ void p0b_tail(const Args& a, LAS unsigned char* lds, int wave, int lane, unsigned* ctl, volatile LAS unsigned* bc) {
    { int t_ = lane_id(); asm volatile("" : "+v"(t_)); lane = t_; }
    LAS float* scr = (LAS float*)(lds + wave * 16384);
    constexpr int NCH = (NITEMS - NITEMS_A + 7) / 8;
    for (;;) { __syncthreads();
        if (wave == 0 && lane_id() == 0) *bc = __hip_atomic_fetch_add(ctl + CW_Q + 64 * 7, 1u, __ATOMIC_RELAXED, __HIP_MEMORY_SCOPE_AGENT);
        __syncthreads();
        const unsigned c = *bc; if (c >= (unsigned)NCH) break;
        const int it = NITEMS_A + 8 * (int)c + wave;
        if (it < NITEMS) p0_item(a, scr, it, lane);
    }
}
template <bool FIRST, int XS, int PUB>
__device__ __forceinline__ void norm_res_tail(const Args& a, const float* wpost_, const float* wpre_, int wave, int lane, unsigned* ctl, int bank, volatile LAS unsigned* bc) {
    { int t_ = lane_id(); asm volatile("" : "+v"(t_)); lane = t_; }
    const GAS f32x4* wp4 = (const GAS f32x4*)wpost_ + lane;
    f32x4 wpost[4], wpre[4];
#pragma unroll
    for (int j = 0; j < 4; ++j) { wpost[j] = wp4[64 * j]; wpre[j] = wpre_ ? ((const GAS f32x4*)wpre_ + lane)[64 * j] : (f32x4){0.f, 0.f, 0.f, 0.f}; }
    const GAS float* stats = (const GAS float*)(a.ws + WS_STATS);
    const bf16* Y = (const bf16*)(a.ws + WS_Y); const bf16* PX = (const bf16*)(a.ws + WS_Y2); bf16* HN = (bf16*)(a.ws + WS_HN);
    int prev_panel = -1;
    for (;;) { __syncthreads();
        if (wave == 0 && lane_id() == 0) {
            if (PUB >= 0 && prev_panel >= 0) __hip_atomic_fetch_add(ctl + CW_CNT + (PUB >= 0 ? PUB : 0) * CW_BANK + 64 * prev_panel, 1u, __ATOMIC_RELAXED, __HIP_MEMORY_SCOPE_AGENT);
            const unsigned c_ = __hip_atomic_fetch_add(ctl + CW_Q + 64 * bank, 1u, __ATOMIC_RELAXED, __HIP_MEMORY_SCOPE_AGENT);
            if (c_ < (unsigned)(MR / 32)) { const int p_ = (int)c_ >> 3; unsigned sp_ = 0;
                while (ld_rlx(ctl + CW_CNT + bank * CW_BANK + 64 * p_) < (unsigned)(p_ < 64 ? 32 : 32 * XS)) { __builtin_amdgcn_s_sleep(2); if (++sp_ > (1u << 18)) break; }
                __builtin_amdgcn_fence(__ATOMIC_ACQUIRE, "agent"); asm volatile("s_waitcnt vmcnt(0)" ::: "memory"); }
            *bc = c_; }
        __syncthreads();
        const unsigned cu_ = *bc; if (cu_ >= (unsigned)(MR / 32)) break; const int chunk = (int)cu_; prev_panel = chunk >> 3;
    if (chunk * 32 < MAINR) {
#pragma unroll
    for (int k = 0; k < 4; ++k) {
        const int r = chunk * 32 + wave * 4 + k;
        GAS f32x4* xp = (GAS f32x4*)xrow(a, r) + lane; const GAS f32x4* xs = (const GAS f32x4*)xsrc(a, r) + lane;
        GAS v2u* xb = (GAS v2u*)((GAS bf16*)xrow(a, r) + D) + lane;
        const GAS v2u* yp = (const GAS v2u*)(Y + (size_t)r * D) + lane;
        float s = (!false && lane < 16) ? stats[(size_t)r * 16 + lane] : 0.f;
        f32x4 v[4], yf[4]; v2u yy[4], y2[4];
#pragma unroll
        for (int j = 0; j < 4; ++j) { if (FIRST) v[j] = xs[64 * j]; else { const v2u q = xb[64 * j]; v[j] = (f32x4){bflo(q.x), bfhi(q.x), bflo(q.y), bfhi(q.y)}; } yy[j] = false ? (v2u){0u, 0u} : yp[64 * j]; }
#pragma unroll
        for (int j = 0; j < 4; ++j) { f32x4 y; y.x = bflo(yy[j].x); y.y = bfhi(yy[j].x); y.z = bflo(yy[j].y); y.w = bfhi(yy[j].y); yf[j] = y; }
        if (false) {
            v2u pq[XS][4];
#pragma unroll
            for (int sl = 0; sl < XS; ++sl) { const GAS v2u* pp = (const GAS v2u*)(PX + ((size_t)sl * XROWS + (size_t)(r - MAINR)) * D) + lane;
#pragma unroll
                for (int j = 0; j < 4; ++j) pq[sl][j] = pp[64 * j]; }
#pragma unroll
            for (int sl = 0; sl < XS; ++sl)
#pragma unroll
                for (int j = 0; j < 4; ++j) { yf[j].x += bflo(pq[sl][j].x); yf[j].y += bfhi(pq[sl][j].x); yf[j].z += bflo(pq[sl][j].y); yf[j].w += bfhi(pq[sl][j].y); }
#pragma unroll
            for (int j = 0; j < 4; ++j) s += (yf[j].x * yf[j].x + yf[j].y * yf[j].y) + (yf[j].z * yf[j].z + yf[j].w * yf[j].w);
        }
        const float rs = rsqrtf(wave_sum(s) * (1.0f / D) + EPS);
        float ss = 0.f;
#pragma unroll
        for (int j = 0; j < 4; ++j) { const f32x4 y = yf[j];
            v[j] = v[j] + y * rs * wpost[j]; if (wpre_) { v2u q; q.x = pk2(v[j].x, v[j].y); q.y = pk2(v[j].z, v[j].w); if (PUB >= 0) st8_wt(xb + 64 * j, q); else xb[64 * j] = q; } else xp[64 * j] = v[j];
            ss += (v[j].x * v[j].x + v[j].y * v[j].y) + (v[j].z * v[j].z + v[j].w * v[j].w); }
        if (wpre_) {
            const float rs1 = rsqrtf(wave_sum(ss) * (1.0f / D) + EPS);
            GAS v2u* o8 = (GAS v2u*)(HN + (size_t)r * D) + lane;
#pragma unroll
            for (int j = 0; j < 4; ++j) { const f32x4 h = v[j] * rs1 * wpre[j]; v2u o; o.x = pk2(h.x, h.y); o.y = pk2(h.z, h.w); if (PUB >= 0) st8_wt(o8 + 64 * j, o); else o8[64 * j] = o; }
        }
    }
    } else {
#pragma unroll 2
    for (int k = 0; k < 4; ++k) {
        const int r = chunk * 32 + wave * 4 + k;
        GAS f32x4* xp = (GAS f32x4*)xrow(a, r) + lane; const GAS f32x4* xs = (const GAS f32x4*)xsrc(a, r) + lane;
        GAS v2u* xb = (GAS v2u*)((GAS bf16*)xrow(a, r) + D) + lane;
        const GAS v2u* yp = (const GAS v2u*)(Y + (size_t)r * D) + lane;
        float s = (!true && lane < 16) ? stats[(size_t)r * 16 + lane] : 0.f;
        f32x4 v[4], yf[4]; v2u yy[4], y2[4];
#pragma unroll
        for (int j = 0; j < 4; ++j) { if (FIRST) v[j] = xs[64 * j]; else { const v2u q = xb[64 * j]; v[j] = (f32x4){bflo(q.x), bfhi(q.x), bflo(q.y), bfhi(q.y)}; } yy[j] = true ? (v2u){0u, 0u} : yp[64 * j]; }
#pragma unroll
        for (int j = 0; j < 4; ++j) { f32x4 y; y.x = bflo(yy[j].x); y.y = bfhi(yy[j].x); y.z = bflo(yy[j].y); y.w = bfhi(yy[j].y); yf[j] = y; }
        if (true) {
            v2u pq[XS][4];
#pragma unroll
            for (int sl = 0; sl < XS; ++sl) { const GAS v2u* pp = (const GAS v2u*)(PX + ((size_t)sl * XROWS + (size_t)(r - MAINR)) * D) + lane;
#pragma unroll
                for (int j = 0; j < 4; ++j) pq[sl][j] = pp[64 * j]; }
#pragma unroll
            for (int sl = 0; sl < XS; ++sl)
#pragma unroll
                for (int j = 0; j < 4; ++j) { yf[j].x += bflo(pq[sl][j].x); yf[j].y += bfhi(pq[sl][j].x); yf[j].z += bflo(pq[sl][j].y); yf[j].w += bfhi(pq[sl][j].y); }
#pragma unroll
            for (int j = 0; j < 4; ++j) s += (yf[j].x * yf[j].x + yf[j].y * yf[j].y) + (yf[j].z * yf[j].z + yf[j].w * yf[j].w);
        }
        const float rs = rsqrtf(wave_sum(s) * (1.0f / D) + EPS);
        float ss = 0.f;
#pragma unroll
        for (int j = 0; j < 4; ++j) { const f32x4 y = yf[j];
            v[j] = v[j] + y * rs * wpost[j]; if (wpre_) { v2u q; q.x = pk2(v[j].x, v[j].y); q.y = pk2(v[j].z, v[j].w); if (PUB >= 0) st8_wt(xb + 64 * j, q); else xb[64 * j] = q; } else xp[64 * j] = v[j];
            ss += (v[j].x * v[j].x + v[j].y * v[j].y) + (v[j].z * v[j].z + v[j].w * v[j].w); }
        if (wpre_) {
            const float rs1 = rsqrtf(wave_sum(ss) * (1.0f / D) + EPS);
            GAS v2u* o8 = (GAS v2u*)(HN + (size_t)r * D) + lane;
#pragma unroll
            for (int j = 0; j < 4; ++j) { const f32x4 h = v[j] * rs1 * wpre[j]; v2u o; o.x = pk2(h.x, h.y); o.y = pk2(h.z, h.w); if (PUB >= 0) st8_wt(o8 + 64 * j, o); else o8[64 * j] = o; }
        }
    }
    }
    if (PUB >= 0) asm volatile("s_waitcnt vmcnt(0)" ::: "memory");
    TAIL_END
}

__device__ __forceinline__ void rgconv_tail(const Args& a, unsigned* ctl, volatile LAS unsigned* bc, const int wave) {
    int tidx = wave * 64 + lane_id(); asm volatile("" : "+v"(tidx));
    const bf16* XR = (const bf16*)(a.ws + WS_R1B); bf16* XC = (bf16*)(a.ws + WS_HN);
    const GAS float* cw = (const GAS float*)a.in[11]; const GAS float* cb = (const GAS float*)a.in[12]; const GAS float* st = (const GAS float*)a.in[2];
    const int ch0 = 8 * (tidx & 127);
    float w[4][8], bb[8];
#pragma unroll
    for (int k = 0; k < 4; ++k) { const f32x4 w0 = *(const GAS f32x4*)(cw + k * D + ch0), w1 = *(const GAS f32x4*)(cw + k * D + ch0 + 4);
        w[k][0] = w0.x; w[k][1] = w0.y; w[k][2] = w0.z; w[k][3] = w0.w; w[k][4] = w1.x; w[k][5] = w1.y; w[k][6] = w1.z; w[k][7] = w1.w; }
    { const f32x4 b0 = *(const GAS f32x4*)(cb + ch0), b1 = *(const GAS f32x4*)(cb + ch0 + 4);
        bb[0] = b0.x; bb[1] = b0.y; bb[2] = b0.z; bb[3] = b0.w; bb[4] = b1.x; bb[5] = b1.y; bb[6] = b1.z; bb[7] = b1.w; }
    TAIL_BEGIN(0, MR / 32, 64, (chunk > 0 ? (32 * chunk - 3) >> 8 : 0), (32 * chunk) >> 8)
    if (32 * chunk < NPR) {
        const int R0 = 32 * chunk + 8 * (tidx >> 7), bq = R0 / TP, t0 = R0 - bq * TP;
        v4u win[11];
#pragma unroll
        for (int wi = 0; wi < 11; ++wi) win[wi] = (t0 - 3 + wi >= 0) ? *(const GAS v4u*)(XR + (size_t)(R0 - 3 + wi) * D + ch0) : (v4u){0u, 0u, 0u, 0u};
#pragma unroll
        for (int i = 0; i < 8; ++i) {
            float c8[8];
#pragma unroll
            for (int e = 0; e < 8; ++e) c8[e] = bb[e];
#pragma unroll
            for (int k = 0; k < 4; ++k) { const v4u q = win[i + k]; const float x[8] = {bflo(q.x), bfhi(q.x), bflo(q.y), bfhi(q.y), bflo(q.z), bfhi(q.z), bflo(q.w), bfhi(q.w)};
#pragma unroll
                for (int e = 0; e < 8; ++e) c8[e] = fmaf(w[k][e], x[e], c8[e]); }
            if (t0 + i >= TP - 3) { const v4u q = win[i + 3]; const float x[8] = {bflo(q.x), bfhi(q.x), bflo(q.y), bfhi(q.y), bflo(q.z), bfhi(q.z), bflo(q.w), bfhi(q.w)};
                GAS float* dst = (GAS float*)a.out + O_RCP + (size_t)(bq * 3 + (t0 + i - (TP - 3))) * D + ch0;
                *(GAS f32x4*)dst = (f32x4){x[0], x[1], x[2], x[3]}; *(GAS f32x4*)(dst + 4) = (f32x4){x[4], x[5], x[6], x[7]}; }
            v4u o; o.x = pk2(c8[0], c8[1]); o.y = pk2(c8[2], c8[3]); o.z = pk2(c8[4], c8[5]); o.w = pk2(c8[6], c8[7]);
            *(GAS v4u*)(XC + (size_t)(R0 + i) * D + ch0) = o;
        }
    } else {
        const int R0 = 32 * chunk + 8 * (tidx >> 7);
#pragma unroll
        for (int h2 = 0; h2 < 2; ++h2) {
            const int Rs = R0 + 4 * h2, sb = (Rs - NPR) >> 2;
            float win[7][8];
#pragma unroll
            for (int wi = 0; wi < 3; ++wi) { const GAS float* sp = st + (size_t)(sb * 3 + wi) * D + ch0; const f32x4 q0 = *(const GAS f32x4*)sp, q1 = *(const GAS f32x4*)(sp + 4);
                win[wi][0] = q0.x; win[wi][1] = q0.y; win[wi][2] = q0.z; win[wi][3] = q0.w; win[wi][4] = q1.x; win[wi][5] = q1.y; win[wi][6] = q1.z; win[wi][7] = q1.w; }
#pragma unroll
            for (int wi = 3; wi < 7; ++wi) { const v4u q = *(const GAS v4u*)(XR + (size_t)(Rs + wi - 3) * D + ch0);
                win[wi][0] = bflo(q.x); win[wi][1] = bfhi(q.x); win[wi][2] = bflo(q.y); win[wi][3] = bfhi(q.y); win[wi][4] = bflo(q.z); win[wi][5] = bfhi(q.z); win[wi][6] = bflo(q.w); win[wi][7] = bfhi(q.w); }
#pragma unroll
            for (int i = 0; i < 4; ++i) {
                float c8[8];
#pragma unroll
                for (int e = 0; e < 8; ++e) c8[e] = bb[e];
#pragma unroll
                for (int k = 0; k < 4; ++k)
#pragma unroll
                    for (int e = 0; e < 8; ++e) c8[e] = fmaf(w[k][e], win[i + k][e], c8[e]);
                if (i >= 1) {
                    GAS float* dst = (GAS float*)a.out + O_RCS + (size_t)(sb * 3 + (i - 1)) * D + ch0;
                    *(GAS f32x4*)dst = (f32x4){win[i + 3][0], win[i + 3][1], win[i + 3][2], win[i + 3][3]}; *(GAS f32x4*)(dst + 4) = (f32x4){win[i + 3][4], win[i + 3][5], win[i + 3][6], win[i + 3][7]}; }
                v4u o; o.x = pk2(c8[0], c8[1]); o.y = pk2(c8[2], c8[3]); o.z = pk2(c8[4], c8[5]); o.w = pk2(c8[6], c8[7]);
                *(GAS v4u*)(XC + (size_t)(Rs + i) * D + ch0) = o;
            }
        }
    }
    TAIL_END
}

__device__ __forceinline__ bool seq_start(int R) { return R < NPR ? (R % TP == 0) : (((R - NPR) & 3) == 0); }
__device__ __forceinline__ bool seq_end(int R) { return R < NPR ? (R % TP == TP - 1) : (((R - NPR) & 3) == 3); }
template <int PASS>
__device__ __forceinline__ void lru_scan_item(const Args& a, LAS unsigned char* lds, const int j, const int q, const int wave, unsigned* ctl = nullptr) {
    int tid_ = wave * 64 + lane_id(); asm volatile("" : "+v"(tid_));
    const int tid = tid_, sub = tid >> 5, oct = tid & 31;
    const bf16* OMA = (const bf16*)(a.ws + WS_Y); const bf16* U = (const bf16*)(a.ws + WS_R1B); const bf16* GG = (const bf16*)(a.ws + WS_R1); bf16* A2 = (bf16*)(a.ws + WS_HN);
    GAS float* AGG = (GAS float*)(a.ws + WS_AGG); const GAS float* sth = (const GAS float*)a.in[3];
    LAS float* sagg = (LAS float*)lds;
    {
        const int ch0 = 256 * q + 8 * oct, Rb = 64 * j + 4 * sub;
        v4u qa[4], qu[4], gq[4];
#pragma unroll
        for (int rr = 0; rr < 4; ++rr) { qa[rr] = *(const GAS v4u*)(OMA + (size_t)(Rb + rr) * D + ch0); qu[rr] = *(const GAS v4u*)(U + (size_t)(Rb + rr) * D + ch0);
            if (PASS == 2) gq[rr] = *(const GAS v4u*)(GG + (size_t)(Rb + rr) * D + ch0); }
        float av[4][8], uv[4][8], h0[4][8];
#pragma unroll
        for (int rr = 0; rr < 4; ++rr) {
            av[rr][0] = 1.f - bflo(qa[rr].x); av[rr][1] = 1.f - bfhi(qa[rr].x); av[rr][2] = 1.f - bflo(qa[rr].y); av[rr][3] = 1.f - bfhi(qa[rr].y);
            av[rr][4] = 1.f - bflo(qa[rr].z); av[rr][5] = 1.f - bfhi(qa[rr].z); av[rr][6] = 1.f - bflo(qa[rr].w); av[rr][7] = 1.f - bfhi(qa[rr].w);
            uv[rr][0] = bflo(qu[rr].x); uv[rr][1] = bfhi(qu[rr].x); uv[rr][2] = bflo(qu[rr].y); uv[rr][3] = bfhi(qu[rr].y);
            uv[rr][4] = bflo(qu[rr].z); uv[rr][5] = bfhi(qu[rr].z); uv[rr][6] = bflo(qu[rr].w); uv[rr][7] = bfhi(qu[rr].w);
            const int R = Rb + rr;
            if (R >= NPR && ((R - NPR) & 3) == 0) { const GAS float* hp = sth + (size_t)((R - NPR) >> 2) * D + ch0; const f32x4 p0 = *(const GAS f32x4*)hp, p1 = *(const GAS f32x4*)(hp + 4);
                h0[rr][0] = p0.x; h0[rr][1] = p0.y; h0[rr][2] = p0.z; h0[rr][3] = p0.w; h0[rr][4] = p1.x; h0[rr][5] = p1.y; h0[rr][6] = p1.z; h0[rr][7] = p1.w; }
            else {
#pragma unroll
                for (int e = 0; e < 8; ++e) h0[rr][e] = 0.f; }
        }
        const bool lookback = (PASS == 2) && (64 * j < NPR);
        if (lookback) {
            const int jt0 = (((64 * j) / TP) * TP) >> 6, n = j - jt0;
            float SA[8], SH[8];
#pragma unroll
            for (int e = 0; e < 8; ++e) { SA[e] = 1.f; SH[e] = 0.f; }
            f32x4 ev[3][4];
#pragma unroll
            for (int k = 0; k < 3; ++k) { const int idx = 3 * sub + k; const GAS f32x4* src = (const GAS f32x4*)(AGG + ((size_t)(jt0 + (idx < n ? idx : 0)) * D + ch0) * 2);
#pragma unroll
                for (int e = 0; e < 4; ++e) ev[k][e] = src[e]; }
#pragma unroll
            for (int k = 0; k < 3; ++k) if (3 * sub + k < n) {
#pragma unroll
                for (int e = 0; e < 4; ++e) { const f32x4 v = ev[k][e]; SH[2 * e] = fmaf(v.x, SH[2 * e], v.y); SA[2 * e] *= v.x; SH[2 * e + 1] = fmaf(v.z, SH[2 * e + 1], v.w); SA[2 * e + 1] *= v.z; } }
            LAS f32x4* dst = (LAS f32x4*)(sagg + 8192 + (size_t)(sub * 256 + 8 * oct) * 2);
#pragma unroll
            for (int e = 0; e < 4; ++e) dst[e] = (f32x4){SA[2 * e], SH[2 * e], SA[2 * e + 1], SH[2 * e + 1]};
        }
        float A8[8], H8[8];
#pragma unroll
        for (int e = 0; e < 8; ++e) { A8[e] = 1.f; H8[e] = 0.f; }
#pragma unroll
        for (int rr = 0; rr < 4; ++rr) { const bool st = seq_start(Rb + rr);
#pragma unroll
            for (int e = 0; e < 8; ++e) { const float hp = st ? h0[rr][e] : H8[e]; H8[e] = fmaf(av[rr][e], hp, uv[rr][e]); A8[e] = st ? 0.f : A8[e] * av[rr][e]; } }
        { LAS f32x4* dst = (LAS f32x4*)(sagg + (size_t)(sub * 256 + 8 * oct) * 2);
#pragma unroll
            for (int e = 0; e < 4; ++e) dst[e] = (f32x4){A8[2 * e], H8[2 * e], A8[2 * e + 1], H8[2 * e + 1]}; }
        __syncthreads();
        if (PASS == 1) {
            if (tid < 32) {
                float A[8], H[8];
#pragma unroll
                for (int e = 0; e < 8; ++e) { A[e] = 1.f; H[e] = 0.f; }
#pragma unroll 4
                for (int s = 0; s < 16; ++s) { const LAS f32x4* src = (const LAS f32x4*)(sagg + (size_t)(s * 256 + 8 * oct) * 2);
#pragma unroll
                    for (int e = 0; e < 4; ++e) { const f32x4 v = src[e]; H[2 * e] = fmaf(v.x, H[2 * e], v.y); A[2 * e] *= v.x; H[2 * e + 1] = fmaf(v.z, H[2 * e + 1], v.w); A[2 * e + 1] *= v.z; } }
                GAS f32x4* dst = (GAS f32x4*)(AGG + ((size_t)j * D + ch0) * 2);
#pragma unroll
                for (int e = 0; e < 4; ++e) st16f_wt(dst + e, (f32x4){A[2 * e], H[2 * e], A[2 * e + 1], H[2 * e + 1]});
                asm volatile("s_waitcnt vmcnt(0)" ::: "memory");
            }
        } else {
            float C8[8];
#pragma unroll
            for (int e = 0; e < 8; ++e) C8[e] = 0.f;
            if (lookback) {
                LAS float* tcar = sagg + 16384;
                if (tid < 32) {
#pragma unroll 4
                    for (int sg = 0; sg < 16; ++sg) { const LAS f32x4* src = (const LAS f32x4*)(sagg + 8192 + (size_t)(sg * 256 + 8 * oct) * 2);
#pragma unroll
                        for (int e = 0; e < 4; ++e) { const f32x4 v = src[e]; C8[2 * e] = fmaf(v.x, C8[2 * e], v.y); C8[2 * e + 1] = fmaf(v.z, C8[2 * e + 1], v.w); } }
                    *(LAS f32x4*)(tcar + 8 * oct) = (f32x4){C8[0], C8[1], C8[2], C8[3]}; *(LAS f32x4*)(tcar + 8 * oct + 4) = (f32x4){C8[4], C8[5], C8[6], C8[7]};
                }
                __syncthreads();
                const f32x4 c0 = *(const LAS f32x4*)(tcar + 8 * oct), c1 = *(const LAS f32x4*)(tcar + 8 * oct + 4);
                C8[0] = c0.x; C8[1] = c0.y; C8[2] = c0.z; C8[3] = c0.w; C8[4] = c1.x; C8[5] = c1.y; C8[6] = c1.z; C8[7] = c1.w;
            }
            for (int s = 0; s < sub; ++s) { const LAS f32x4* src = (const LAS f32x4*)(sagg + (size_t)(s * 256 + 8 * oct) * 2);
#pragma unroll
                for (int e = 0; e < 4; ++e) { const f32x4 v = src[e]; C8[2 * e] = fmaf(v.x, C8[2 * e], v.y); C8[2 * e + 1] = fmaf(v.z, C8[2 * e + 1], v.w); } }
#pragma unroll
            for (int rr = 0; rr < 4; ++rr) { const int R = Rb + rr; const bool st = seq_start(R);
                const v4u g = gq[rr];
#pragma unroll
                for (int e = 0; e < 8; ++e) { const float hp = st ? h0[rr][e] : C8[e]; C8[e] = fmaf(av[rr][e], hp, uv[rr][e]); }
                v4u o; o.x = pk2(C8[0] * bflo(g.x), C8[1] * bfhi(g.x)); o.y = pk2(C8[2] * bflo(g.y), C8[3] * bfhi(g.y));
                o.z = pk2(C8[4] * bflo(g.z), C8[5] * bfhi(g.z)); o.w = pk2(C8[6] * bflo(g.w), C8[7] * bfhi(g.w));
                st16_wt(A2 + (size_t)R * D + ch0, o);
                if (seq_end(R)) { GAS float* dst = (GAS float*)a.out + (R < NPR ? O_RHP + (size_t)(R / TP) * D : O_RHS + (size_t)((R - NPR) >> 2) * D) + ch0;
                    *(GAS f32x4*)dst = (f32x4){C8[0], C8[1], C8[2], C8[3]}; *(GAS f32x4*)(dst + 4) = (f32x4){C8[4], C8[5], C8[6], C8[7]}; }
            }
            asm volatile("s_waitcnt vmcnt(0)" ::: "memory");
        }
        __syncthreads();
        if (PASS == 2 && wave == 0 && lane_id() == 0) {
            __hip_atomic_fetch_add(ctl + CW_CNT + 12 * CW_BANK + 64 * (j >> 2), 1u, __ATOMIC_RELAXED, __HIP_MEMORY_SCOPE_AGENT);
            __hip_atomic_fetch_add(ctl + CW_CNT + 12 * CW_BANK + 64 * 100, 1u, __ATOMIC_RELAXED, __HIP_MEMORY_SCOPE_AGENT); }
    }
}

__device__ __forceinline__ void lru_scan1_tail(const Args& a, LAS unsigned char* lds, unsigned* ctl, volatile LAS unsigned* bc, const int wave) {
    TAIL_BEGIN(1, 266 * 2, 64, chunk >> 3, chunk >> 3)
    lru_scan_item<1>(a, lds, chunk >> 1, 2 * (chunk & 1), wave); lru_scan_item<1>(a, lds, chunk >> 1, 2 * (chunk & 1) + 1, wave);
    if (wave == 0 && lane_id() == 0) __hip_atomic_fetch_add(ctl + CW_CNT + 13 * CW_BANK + 16 * (chunk >> 1), 1u, __ATOMIC_RELAXED, __HIP_MEMORY_SCOPE_AGENT);
    TAIL_END
}
__device__ __forceinline__ void lru_scan2_phase(const Args& a, LAS unsigned char* lds, const int wave, unsigned* ctl) {
#pragma unroll 1
    for (int it = blockIdx.x; it < 266 * 4; it += gridDim.x) {
        const int j = it >> 2;
        if (wave == 0) {
            const int jt0 = (64 * j < NPR) ? ((((64 * j) / TP) * TP) >> 6) : j, n = j - jt0, l = lane_id();
            unsigned* w = (l < n) ? ctl + CW_CNT + 13 * CW_BANK + 16 * (jt0 + l) : ctl + CW_CNT + 1 * CW_BANK + 64 * (j >> 2);
            const unsigned nd = (l < n) ? 2u : (l == n ? 64u : 0u);
            unsigned sp = 0;
            while (!__all(__hip_atomic_load(w, __ATOMIC_RELAXED, __HIP_MEMORY_SCOPE_AGENT) >= nd)) { __builtin_amdgcn_s_sleep(2); if (++sp > (1u << 18)) break; }
            __builtin_amdgcn_fence(__ATOMIC_ACQUIRE, "agent"); asm volatile("s_waitcnt vmcnt(0)" ::: "memory");
        }
        __syncthreads();
        lru_scan_item<2>(a, lds, j, it & 3, wave, ctl);
    }
}

__device__ __forceinline__ void sconv_tail(const Args& a, unsigned* ctl, volatile LAS unsigned* bc, const int wave) {
    int tidx = wave * 64 + lane_id(); asm volatile("" : "+v"(tidx));
    const bf16* BG = (const bf16*)(a.ws + WS_R1); const bf16* CV = (const bf16*)(a.ws + WS_R1B); bf16* A3 = (bf16*)(a.ws + WS_HN);
    const GAS float* cw = (const GAS float*)a.in[20]; const GAS float* st = (const GAS float*)a.in[4];
    const int ch0 = 8 * (tidx & 127);
    float w[3][8];
#pragma unroll
    for (int k = 0; k < 3; ++k) { const f32x4 w0 = *(const GAS f32x4*)(cw + k * D + ch0), w1 = *(const GAS f32x4*)(cw + k * D + ch0 + 4);
        w[k][0] = w0.x; w[k][1] = w0.y; w[k][2] = w0.z; w[k][3] = w0.w; w[k][4] = w1.x; w[k][5] = w1.y; w[k][6] = w1.z; w[k][7] = w1.w; }
    TAIL_BEGIN_PUB(4, 10, MR / 32, 96, (chunk > 0 ? (32 * chunk - 2) >> 8 : 0), (32 * chunk) >> 8)
    if (32 * chunk < NPR) {
        const int R0 = 32 * chunk + 8 * (tidx >> 7), bq = R0 / TP, t0 = R0 - bq * TP;
        v4u win[10], bgq[8];
#pragma unroll
        for (int wi = 0; wi < 10; ++wi) win[wi] = (t0 - 2 + wi >= 0) ? *(const GAS v4u*)(CV + (size_t)(R0 - 2 + wi) * D + ch0) : (v4u){0u, 0u, 0u, 0u};
#pragma unroll
        for (int i = 0; i < 8; ++i) bgq[i] = *(const GAS v4u*)(BG + (size_t)(R0 + i) * D + ch0);
#pragma unroll
        for (int i = 0; i < 8; ++i) {
            float c8[8];
#pragma unroll
            for (int e = 0; e < 8; ++e) c8[e] = 0.f;
#pragma unroll
            for (int k = 0; k < 3; ++k) { const v4u q = win[i + k]; const float x[8] = {bflo(q.x), bfhi(q.x), bflo(q.y), bfhi(q.y), bflo(q.z), bfhi(q.z), bflo(q.w), bfhi(q.w)};
#pragma unroll
                for (int e = 0; e < 8; ++e) c8[e] = fmaf(w[k][e], x[e], c8[e]); }
            if (t0 + i >= TP - 2) { const v4u q = win[i + 2]; const float x[8] = {bflo(q.x), bfhi(q.x), bflo(q.y), bfhi(q.y), bflo(q.z), bfhi(q.z), bflo(q.w), bfhi(q.w)};
                GAS float* dst = (GAS float*)a.out + O_SCP + (size_t)(bq * 2 + (t0 + i - (TP - 2))) * D + ch0;
                *(GAS f32x4*)dst = (f32x4){x[0], x[1], x[2], x[3]}; *(GAS f32x4*)(dst + 4) = (f32x4){x[4], x[5], x[6], x[7]}; }
            const v4u g = bgq[i];
            v4u o; o.x = pk2(bflo(g.x) * c8[0], bfhi(g.x) * c8[1]); o.y = pk2(bflo(g.y) * c8[2], bfhi(g.y) * c8[3]);
            o.z = pk2(bflo(g.z) * c8[4], bfhi(g.z) * c8[5]); o.w = pk2(bflo(g.w) * c8[6], bfhi(g.w) * c8[7]);
            st16_wt(A3 + (size_t)(R0 + i) * D + ch0, o);
        }
    } else {
        const int R0 = 32 * chunk + 8 * (tidx >> 7);
#pragma unroll
        for (int h2 = 0; h2 < 2; ++h2) {
            const int Rs = R0 + 4 * h2, sb = (Rs - NPR) >> 2;
            float win[6][8]; v4u bgq[4];
#pragma unroll
            for (int wi = 0; wi < 2; ++wi) { const GAS float* sp = st + (size_t)(sb * 2 + wi) * D + ch0; const f32x4 q0 = *(const GAS f32x4*)sp, q1 = *(const GAS f32x4*)(sp + 4);
                win[wi][0] = q0.x; win[wi][1] = q0.y; win[wi][2] = q0.z; win[wi][3] = q0.w; win[wi][4] = q1.x; win[wi][5] = q1.y; win[wi][6] = q1.z; win[wi][7] = q1.w; }
#pragma unroll
            for (int wi = 2; wi < 6; ++wi) { const v4u q = *(const GAS v4u*)(CV + (size_t)(Rs + wi - 2) * D + ch0);
                win[wi][0] = bflo(q.x); win[wi][1] = bfhi(q.x); win[wi][2] = bflo(q.y); win[wi][3] = bfhi(q.y); win[wi][4] = bflo(q.z); win[wi][5] = bfhi(q.z); win[wi][6] = bflo(q.w); win[wi][7] = bfhi(q.w); }
#pragma unroll
            for (int i = 0; i < 4; ++i) bgq[i] = *(const GAS v4u*)(BG + (size_t)(Rs + i) * D + ch0);
#pragma unroll
            for (int i = 0; i < 4; ++i) {
                float c8[8];
#pragma unroll
                for (int e = 0; e < 8; ++e) c8[e] = 0.f;
#pragma unroll
                for (int k = 0; k < 3; ++k)
#pragma unroll
                    for (int e = 0; e < 8; ++e) c8[e] = fmaf(w[k][e], win[i + k][e], c8[e]);
                if (i >= 2) {
                    GAS float* dst = (GAS float*)a.out + O_SCS + (size_t)(sb * 2 + (i - 2)) * D + ch0;
                    *(GAS f32x4*)dst = (f32x4){win[i + 2][0], win[i + 2][1], win[i + 2][2], win[i + 2][3]}; *(GAS f32x4*)(dst + 4) = (f32x4){win[i + 2][4], win[i + 2][5], win[i + 2][6], win[i + 2][7]}; }
                const v4u g = bgq[i];
                v4u o; o.x = pk2(bflo(g.x) * c8[0], bfhi(g.x) * c8[1]); o.y = pk2(bflo(g.y) * c8[2], bfhi(g.y) * c8[3]);
                o.z = pk2(bflo(g.z) * c8[4], bfhi(g.z) * c8[5]); o.w = pk2(bflo(g.w) * c8[6], bfhi(g.w) * c8[7]);
                st16_wt(A3 + (size_t)(Rs + i) * D + ch0, o);
            }
        }
    }
    asm volatile("s_waitcnt vmcnt(0)" ::: "memory");
    TAIL_END
}

#define XB_TMO      128
#define XB_XCNT(j)  (256  + 64 * (j))
#define XB_XSUB(j)  (1280 + 64 * (j))
#define XB_XGEN(j)  (2304 + 64 * (j))
#define XB_TOP      3328
#define XB_TOPGEN   3392
#define XCD_BAR_WORDS 3456
#define XB_SPIN_CAP (1u << 18)

__device__ __forceinline__ unsigned xb_ld(unsigned* p)              { return __hip_atomic_load(p, __ATOMIC_RELAXED, __HIP_MEMORY_SCOPE_AGENT); }
__device__ __forceinline__ unsigned xb_add(unsigned* p, unsigned v) { return __hip_atomic_fetch_add(p, v, __ATOMIC_RELAXED, __HIP_MEMORY_SCOPE_AGENT); }
__device__ __forceinline__ unsigned xb_xcc_id() { return (unsigned)__builtin_amdgcn_s_getreg((3 << 11) | 20) & 0xFu; }
#define XB_SPIN(cond, bar) do { unsigned _sp = 0; while (cond) { __builtin_amdgcn_s_sleep(1); \
    if ((++_sp & 255u) == 0u) { if (xb_ld(&(bar)[XB_TMO])) break; if (_sp > XB_SPIN_CAP) { atomicAdd(&(bar)[XB_TMO], 1u); break; } } } } while (0)

struct XcdBarrier {
    unsigned* bar; unsigned x;
    volatile LAS unsigned* st;
};

__device__ __forceinline__ XcdBarrier xcd_barrier_post(unsigned* bar, volatile LAS unsigned* st, const int wave) {
    XcdBarrier b; b.bar = bar; b.x = xb_xcc_id(); b.st = st;
    if (wave == 0 && lane_id() == 0) (void)xb_add(&bar[XB_XCNT(b.x)], 1u);
    return b;
}
__device__ __forceinline__ void xcd_barrier_complete(unsigned* bar, unsigned x, unsigned& nloc, unsigned& nx) {
    const unsigned G = gridDim.x * gridDim.y * gridDim.z;
    unsigned sum, cnt, mine, sp = 0u;
    for (;;) {
        sum = 0u; cnt = 0u; mine = 0u;
#pragma unroll
        for (unsigned j = 0; j < 16; ++j) { const unsigned c = xb_ld(&bar[XB_XCNT(j)]); sum += c; cnt += (c > 0u) ? 1u : 0u; mine = (j == x) ? c : mine; }
        if (sum == G) break;
        __builtin_amdgcn_s_sleep(1);
        if ((++sp & 255u) == 0u) { if (xb_ld(&bar[XB_TMO])) break; if (sp > XB_SPIN_CAP) { atomicAdd(&bar[XB_TMO], 1u); break; } }
    }
    nloc = mine > 0u ? mine : 1u; nx = cnt > 0u ? cnt : 1u;
}

__device__ __forceinline__ void xcd_barrier(const XcdBarrier& b, const int wave) {
    asm volatile("s_waitcnt vmcnt(0)" ::: "memory");
    __syncthreads();
    if (wave == 0 && lane_id() == 0) {
        unsigned* bar = b.bar;
        __builtin_amdgcn_s_waitcnt(0);
        unsigned nloc = b.st[0], nx = b.st[1];
        if (nloc == 0u) { xcd_barrier_complete(bar, b.x, nloc, nx); b.st[0] = nloc; b.st[1] = nx; }
        const unsigned old = xb_add(&bar[XB_XSUB(b.x)], 1u);
        const unsigned gen = old / nloc;
        if (old + 1u == (gen + 1u) * nloc) {
            __builtin_amdgcn_fence(__ATOMIC_RELEASE, "agent");
            asm volatile("s_waitcnt vmcnt(0)" ::: "memory");
            const unsigned og = xb_add(&bar[XB_TOP], 1u);
            const unsigned tg = og / nx;
            if (og + 1u == (tg + 1u) * nx) xb_add(&bar[XB_TOPGEN], 1u);
            else XB_SPIN(xb_ld(&bar[XB_TOPGEN]) == tg, bar);
            __builtin_amdgcn_fence(__ATOMIC_ACQUIRE, "agent");
            xb_add(&bar[XB_XGEN(b.x)], 1u);
            asm volatile("s_waitcnt vmcnt(0)" ::: "memory");
        } else {
            XB_SPIN(xb_ld(&bar[XB_XGEN(b.x)]) == gen, bar);
            __builtin_amdgcn_fence(__ATOMIC_ACQUIRE, "agent");
            asm volatile("s_waitcnt vmcnt(0)" ::: "memory");
        }
    }
    __syncthreads();
}

__global__ void __launch_bounds__(512, 2) fwd_kernel(Args a) {
    extern __shared__ __attribute__((aligned(16))) unsigned char lds_raw[];
    LAS unsigned char* lds = (LAS unsigned char*)lds_raw;
    cg::grid_group grid = cg::this_grid();
    const int wave = __builtin_amdgcn_readfirstlane((int)threadIdx.x >> 6), lane = lane_id(), tid = wave * 64 + lane;
    unsigned char* ws = a.ws;
    bf16* HN = (bf16*)(ws + WS_HN); bf16* Y = (bf16*)(ws + WS_Y); bf16* R1 = (bf16*)(ws + WS_R1); bf16* R1B = (bf16*)(ws + WS_R1B);
    float* STATS = (float*)(ws + WS_STATS);
#define GEMM_STEP(BANK, Aptr, Bptr, NN, KK, MODE, OUT0, OUT1) GEMM_STEP_M(BANK, MP, Aptr, Bptr, NN, KK, MODE, OUT0, OUT1)
#define GEMM_STEP_M(BANK, MROWS, Aptr, Bptr, NN, KK, MODE, OUT0, OUT1) do { pg8::Gemm g; g.A = (Aptr); g.Bt = (Bptr); g.M = (MROWS); g.N = (NN); g.K = (KK); g.lda = (KK); g.ldb = (KK); g.kmode = 0; g.ksl = 1; \
        EpiGen E; E.mode = (MODE); E.O0 = (OUT0); E.O1 = (OUT1); E.stats = STATS; E.XC = nullptr; E.pa = nullptr; E.pb = nullptr; E.pl = nullptr; E.ksl = 1; \
        PubOrder S; S.init((MROWS), (NN), (int)gridDim.x, (int)blockIdx.x, (BANK) == 7 ? 8 : 1); S.cnt = ctl + CW_CNT + (BANK) * CW_BANK; \
        if ((BANK) == 7) pg8::gemm_phase<EpiGen, pg8::StaticOrder, true, true>(lds, g, S, E, wave); else pg8::gemm_phase<EpiGen, PubOrder, true, true>(lds, g, S, E, wave); } while (0)
    volatile LAS unsigned* st = (volatile LAS unsigned*)(lds + 131072 + 64);
    if (tid < 2) st[tid] = 0u;
    unsigned* barw = (unsigned*)ws;
    unsigned* ctl = (unsigned*)ws;
    volatile LAS unsigned* bc = (volatile LAS unsigned*)(lds + 131072 + 128);
#define GU_STEP(RBANK, Bptr, GREADY, GNEED) do { pg8::Gemm g; g.A = HN; g.Bt = (Bptr); g.M = MP; g.N = 5632; g.K = 1024; g.lda = 1024; g.ldb = 1024; g.kmode = 0; g.ksl = 1; \
        EpiGen E; E.mode = 1; E.O0 = R1; E.O1 = nullptr; E.stats = STATS; E.XC = nullptr; E.pa = nullptr; E.pb = nullptr; E.pl = nullptr; E.ksl = 1; \
        CountedOrder S; S.init(MP, 5632, (int)gridDim.x, (int)blockIdx.x, 4); S.ready = ctl + CW_CNT + (RBANK) * CW_BANK; S.need = 8u; S.need66 = 4u; S.gready = (GREADY); S.gneed = (GNEED); S.wv = wave; S.gcnt = nullptr; S.cnt = ctl + CW_CNT + 7 * CW_BANK; \
        pg8::gemm_phase<EpiGen, CountedOrder, true, true>(lds, g, S, E, wave); } while (0)

#define DOWNM_STEP(BANK, Bptr, GUNEED, GCNT) do { pg8::Gemm g; g.A = R1; g.Bt = (Bptr); g.M = MAINR; g.N = 1024; g.K = DFF; g.lda = DFF; g.ldb = DFF; g.kmode = 0; g.ksl = 1; \
        EpiGen E; E.mode = 3; E.O0 = Y; E.O1 = nullptr; E.stats = STATS; E.XC = nullptr; E.pa = nullptr; E.pb = nullptr; E.pl = nullptr; E.ksl = 1; \
        CountedOrder S; S.init(MAINR, 1024, (int)gridDim.x, (int)blockIdx.x, 1); S.ready = ctl + CW_CNT + 7 * CW_BANK; S.need = (GUNEED); S.need66 = (GUNEED); S.gready = nullptr; S.gneed = 0u; S.wv = wave; S.gcnt = (GCNT); S.cnt = ctl + CW_CNT + (BANK) * CW_BANK; \
        pg8::gemm_phase<EpiGen, CountedOrder, true, true>(lds, g, S, E, wave); } while (0)
#define DOWNX_STEP(BANK, Bptr, GUNEED, GCNT) do { int kx_ = 256; asm volatile("" : "+s"(kx_)); \
        pg8::Gemm g; g.A = R1; g.Bt = (Bptr); g.M = MP; g.N = 1024; g.K = kx_; g.lda = DFF; g.ldb = DFF; g.kmode = 2; g.ksl = 11; \
        EpiGen E; E.mode = 5; E.O0 = Y; E.O1 = (bf16*)(ws + WS_Y2); E.stats = STATS; E.XC = nullptr; E.pa = nullptr; E.pb = nullptr; E.pl = nullptr; E.ksl = 11; \
        ExtraOrderC S; S.init(MP, 1024, (int)gridDim.x, (int)blockIdx.x, 1); S.ready = ctl + CW_CNT + 7 * CW_BANK; S.need = (GUNEED); S.need66 = (GUNEED); S.gready = nullptr; S.gneed = 0u; S.wv = wave; S.gcnt = (GCNT); S.cnt = ctl + CW_CNT + (BANK) * CW_BANK; S.ksl = 11; \
        pg8::gemm_phase<EpiGen, ExtraOrderC, true, true>(lds, g, S, E, wave); } while (0)
#define OUT_STEP(BANK, Bptr, RBANK, NEEDP, NEED66P) do { { pg8::Gemm g; g.A = HN; g.Bt = (Bptr); g.M = MAINR; g.N = 1024; g.K = 1024; g.lda = 1024; g.ldb = 1024; g.kmode = 0; g.ksl = 1; \
        EpiGen E; E.mode = 3; E.O0 = Y; E.O1 = nullptr; E.stats = STATS; E.XC = nullptr; E.pa = nullptr; E.pb = nullptr; E.pl = nullptr; E.ksl = 1; \
        CountedOrder S; S.init(MAINR, 1024, (int)gridDim.x, (int)blockIdx.x, 1); S.ready = ctl + CW_CNT + (RBANK) * CW_BANK; S.need = (NEEDP); S.need66 = (NEED66P); S.gready = nullptr; S.gneed = 0u; S.wv = wave; S.gcnt = nullptr; S.cnt = ctl + CW_CNT + (BANK) * CW_BANK; \
        pg8::gemm_phase<EpiGen, CountedOrder, true, true>(lds, g, S, E, wave); } \
      { int kx_ = 256; asm volatile("" : "+s"(kx_)); \
        pg8::Gemm g; g.A = HN; g.Bt = (Bptr); g.M = MP; g.N = 1024; g.K = kx_; g.lda = 1024; g.ldb = 1024; g.kmode = 2; g.ksl = 4; \
        EpiGen E; E.mode = 5; E.O0 = Y; E.O1 = (bf16*)(ws + WS_Y2); E.stats = STATS; E.XC = nullptr; E.pa = nullptr; E.pb = nullptr; E.pl = nullptr; E.ksl = 4; \
        ExtraOrderC S; S.init(MP, 1024, (int)gridDim.x, (int)blockIdx.x, 1); S.ready = ctl + CW_CNT + (RBANK) * CW_BANK; S.need = (NEEDP); S.need66 = (NEED66P); S.gready = nullptr; S.gneed = 0u; S.wv = wave; S.gcnt = nullptr; S.cnt = ctl + CW_CNT + (BANK) * CW_BANK; S.ksl = 4; \
        pg8::gemm_phase<EpiGen, ExtraOrderC, true, true>(lds, g, S, E, wave); } } while (0)
#define EXTRA_STEP(BANK, Aptr, Bptr, KTOT, NSL) do { int kx_ = 256; asm volatile("" : "+s"(kx_));     \
        pg8::Gemm g; g.A = (Aptr); g.Bt = (Bptr); g.M = MP; g.N = 1024; g.K = kx_; g.lda = (KTOT); g.ldb = (KTOT); g.kmode = 2; g.ksl = (NSL); \
        EpiGen E; E.mode = 5; E.O0 = Y; E.O1 = (bf16*)(ws + WS_Y2); E.stats = STATS; E.XC = nullptr; E.pa = nullptr; E.pb = nullptr; E.pl = nullptr; E.ksl = (NSL); \
        ExtraOrder S; S.init(MP, 1024, (int)gridDim.x, (int)blockIdx.x, 1); S.cnt = ctl + CW_CNT + (BANK) * CW_BANK; S.ksl = (NSL); \
        pg8::gemm_phase<EpiGen, ExtraOrder, true, true>(lds, g, S, E, wave); } while (0)
    __syncthreads();
    XcdBarrier bar = xcd_barrier_post(barw, st, wave);
#define GSYNC() xcd_barrier(bar, wave)
    if (a.ws == nullptr) grid.sync();
    p0_phase(a, lds, wave, lane); GSYNC();
    GEMM_STEP(0, HN, (const bf16*)(ws + WS_WIN0), 2048, 1024, 0, R1, R1B);
    rgconv_tail(a, ctl, bc, wave); p0b_tail(a, lds, wave, lane, ctl, bc); GSYNC();
    { pg8::Gemm g; g.A = HN; g.Bt = (const bf16*)(ws + WS_WG); g.M = MP; g.N = 2048; g.K = 256; g.lda = 1024; g.ldb = 256; g.kmode = 1; g.ksl = 1;
      EpiGen E; E.mode = 4; E.O0 = Y; E.O1 = R1B; E.stats = STATS; E.ksl = 1; E.XC = HN; E.pa = a.in[14]; E.pb = a.in[16]; E.pl = a.in[17];
      PubOrder S; S.init(MP, 2048, (int)gridDim.x, (int)blockIdx.x, 1); S.cnt = ctl + CW_CNT + 1 * CW_BANK;
      pg8::gemm_phase<EpiGen, PubOrder, true, true>(lds, g, S, E, wave); }
    lru_scan1_tail(a, lds, ctl, bc, wave);
    lru_scan2_phase(a, lds, wave, ctl);
    OUT_STEP(2, (const bf16*)(ws + WS_WOUT0), 12, 16u, 8u);
    norm_res_tail<true, 4, 8>(a, a.in[7], a.in[8], wave, lane, ctl, 2, bc);
    GU_STEP(8, (const bf16*)(ws + WS_WGU), ctl + CW_CNT + 12 * CW_BANK + 64 * 100, 1064u);
    DOWNM_STEP(3, (const bf16*)(ws + WS_WD), 176u, ctl + CW_CNT + 3 * CW_BANK + 64 * 100); DOWNX_STEP(3, (const bf16*)(ws + WS_WD), 176u, ctl + CW_CNT + 3 * CW_BANK + 64 * 100);
    norm_res_tail<false, 11, 11>(a, a.in[9], a.in[6] + D, wave, lane, ctl, 3, bc);
    { pg8::Gemm g; g.A = HN; g.Bt = (const bf16*)(ws + WS_WSCIN); g.M = MP; g.N = 3072; g.K = 1024; g.lda = 1024; g.ldb = 1024; g.kmode = 0; g.ksl = 1;
      EpiGen E; E.mode = 2; E.O0 = R1; E.O1 = R1B; E.stats = STATS; E.XC = nullptr; E.pa = nullptr; E.pb = nullptr; E.pl = nullptr; E.ksl = 1;
      CountedOrder S; S.init(MP, 3072, (int)gridDim.x, (int)blockIdx.x, 1); S.ready = ctl + CW_CNT + 11 * CW_BANK; S.need = 8u; S.need66 = 4u;
      S.gready = ctl + CW_CNT + 3 * CW_BANK + 64 * 100; S.gneed = (256u + 132u) * 8u;
      S.wv = wave; S.gcnt = nullptr; S.cnt = ctl + CW_CNT + 4 * CW_BANK;
      pg8::gemm_phase<EpiGen, CountedOrder, true, true>(lds, g, S, E, wave); }
    sconv_tail(a, ctl, bc, wave);
    OUT_STEP(5, (const bf16*)(ws + WS_WSCOUT), 10, 8u, 4u);
    norm_res_tail<false, 4, 9>(a, a.in[7] + D, a.in[8] + D, wave, lane, ctl, 5, bc);
    GU_STEP(9, (const bf16*)(ws + WS_WGU) + (size_t)5632 * 1024, ctl + CW_CNT + 10 * CW_BANK + 64 * 100, 532u);
    DOWNM_STEP(6, (const bf16*)(ws + WS_WD) + (size_t)1024 * DFF, 352u, nullptr); DOWNX_STEP(6, (const bf16*)(ws + WS_WD) + (size_t)1024 * DFF, 352u, nullptr);
    norm_res_tail<false, 11, -1>(a, a.in[9] + D, nullptr, wave, lane, ctl, 6, bc);
}

extern "C" void kernel_launch(void* const* d_in, const int* in_sizes, int n_in, void* d_out, int out_size, void* d_ws, size_t ws_size, hipStream_t stream) {
    static int grid = 0;
    if (grid == 0) {
        if (n_in != 25 || ws_size < WS_END) { fprintf(stderr, "kernel_launch: unexpected n_in %d / ws_size %zu\n", n_in, ws_size); grid = -1; return; }
        int dev = 0, cus = 0, per_cu = 0;
        hipGetDevice(&dev);
        hipDeviceGetAttribute(&cus, hipDeviceAttributeMultiprocessorCount, dev);
        if (hipFuncSetAttribute((const void*)fwd_kernel, hipFuncAttributeMaxDynamicSharedMemorySize, LDS_BYTES) != hipSuccess) { fprintf(stderr, "kernel_launch: hipFuncSetAttribute failed\n"); grid = -1; return; }
        if (hipOccupancyMaxActiveBlocksPerMultiprocessor(&per_cu, (const void*)fwd_kernel, 512, LDS_BYTES) != hipSuccess || per_cu < 1) { fprintf(stderr, "kernel_launch: occupancy query failed (%d)\n", per_cu); (void)hipGetLastError(); per_cu = 1; }
        grid = cus * per_cu;
        fprintf(stderr, "kernel_launch: %d CUs x %d = grid %d\n", cus, per_cu, grid);
    }
    if (grid < 0) return;
    Args a{};
    for (int i = 0; i < 25; ++i) a.in[i] = (const float*)d_in[i];
    a.out = (float*)d_out; a.ws = (unsigned char*)d_ws;
    if (hipMemsetAsync(d_ws, 0, (size_t)CTL_WORDS * 4, stream) != hipSuccess) { fprintf(stderr, "kernel_launch: memset failed\n"); return; }
    void* args[] = {&a};
    hipError_t e = hipLaunchCooperativeKernel((const void*)fwd_kernel, dim3(grid), dim3(512), args, LDS_BYTES, stream);
    if (e != hipSuccess) fprintf(stderr, "kernel_launch: cooperative launch failed: %s (grid %d)\n", hipGetErrorString(e), grid);
}
```

```cpp
#include <hip/hip_runtime.h>
#include <hip/hip_cooperative_groups.h>
#include <cstdio>
#include <cstdint>
namespace cg = cooperative_groups;
__device__ __forceinline__ int lane_id() { return (int)__builtin_amdgcn_mbcnt_hi(~0u, __builtin_amdgcn_mbcnt_lo(~0u, 0u)); }

namespace pg8 {
#define PG8_LAS __attribute__((address_space(3)))
typedef unsigned short bf16_t;
typedef short bf16x8 __attribute__((ext_vector_type(8)));
typedef float f32x4 __attribute__((ext_vector_type(4)));
typedef unsigned u32x4 __attribute__((ext_vector_type(4)));
constexpr int BM = 256, BK = 64, HALF = 128, HTB = HALF * BK * 2  , STAGE_BYTES = 8 * HTB, NXCD = 8, WGM = 8;

__host__ __device__ __forceinline__ int lds_byte(int r, int c) { const int st = (r >> 4) * 2 + (c >> 5), rr = r & 15, cc = c & 31, ob = rr * 64 + cc * 2; return st * 1024 + (ob ^ (((ob >> 9) & 1) << 5)); }
__host__ __device__ __forceinline__ void stage_rc(int b, int& R, int& C) { const int st = b / 1024, sb = b % 1024, swz = sb ^ (((sb >> 9) & 1) << 5); R = (st >> 1) * 16 + swz / 64; C = (st & 1) * 32 + (swz % 64) / 2; }
__host__ __device__ __forceinline__ int perm32(int rho) { const int n = rho >> 4, i = rho & 15; return 8 * (i >> 2) + 4 * n + (i & 3); }

struct Unit { int pm, pn; };
struct Gemm { const bf16_t* A; const bf16_t* Bt; int M, N, K, lda, ldb, kmode, ksl; };

struct StaticOrder {
    int nM, nN, nwg, G, c, wgm;
    __host__ __device__ void init(int M, int N, int G_, int c_, int wgm_ = WGM) { nM = M / BM; nN = N / BM; nwg = nM * nN; G = G_; c = c_; wgm = wgm_; }
    __host__ __device__ bool next(int i, Unit& u) const {
        const long L = (long)i * G + c; if (L >= nwg) return false;
        int wgid = (int)L; { const int q = nwg / NXCD, r = nwg % NXCD, xcd = wgid % NXCD, off = wgid / NXCD; wgid = (xcd < r ? xcd * (q + 1) : r * (q + 1) + (xcd - r) * q) + off; }
        const int nig = wgm * nN, gid = wgid / nig, fm = gid * wgm, gsz = (nM - fm) < wgm ? (nM - fm) : wgm;
        u.pm = fm + ((wgid % nig) % gsz); u.pn = (wgid % nig) / gsz; return true;
    }
    __device__ __forceinline__ void a_ready(const Unit&) const {}
    __device__ __forceinline__ void done(const Unit&) const {}
};

__device__ __forceinline__ unsigned cvt_pk_bf16(float lo, float hi) { unsigned r; asm volatile("v_cvt_pk_bf16_f32 %0, %1, %2" : "=v"(r) : "v"(lo), "v"(hi)); return r; }

template <class Epi, class Sched, bool ALIGN_EPI = false, bool SP2 = false>
__device__ __forceinline__ void gemm_phase(PG8_LAS unsigned char* lds, const Gemm g, const Sched& S, const Epi& E, const int wave_s) {
    int tid_ = wave_s * 64 + lane_id(); asm volatile("" : "+v"(tid_));
    const int tid = tid_, wid = __builtin_amdgcn_readfirstlane(tid >> 6), lane = tid & 63, wr = wid >> 2, wc = wid & 3, fr = lane & 15, fq = lane >> 4;
    const int K = g.K, nt = K / BK;
    unsigned voffA[2], voffB[2];
#pragma unroll
    for (int i = 0; i < 2; ++i) { int R, C; stage_rc(tid * 16 + i * 8192, R, C); const int Rb = Epi::PERM ? ((R & ~31) + perm32(R & 31)) : R;
        voffA[i] = (unsigned)(R * g.lda + C) * 2u; voffB[i] = (unsigned)(Rb * g.ldb + C) * 2u; }
    const size_t kstep = (size_t)(BK * 2);
    const size_t hstepB = (size_t)HALF * g.ldb * 2, hstepA = (size_t)HALF * g.lda * 2;
    const size_t tstepB = 2 * hstepB, tstepA = 2 * hstepA;
    const unsigned ldsw = (unsigned)wid * 1024u;
    const int aoff = lds_byte(wr * 64 + fr, fq * 8), boff = lds_byte(wc * 32 + fr, fq * 8);
#define PG8_SA(b, h) (((b) * 2 + (h)) * HTB)
#define PG8_SB(b, h) ((4 + (b) * 2 + (h)) * HTB)
#define PG8_STAGE(bufoff, gbase, voff) do { _Pragma("unroll") for (int _i = 0; _i < 2; ++_i) \
        __builtin_amdgcn_global_load_lds((const unsigned*)((const char*)(gbase) + (voff)[_i]), (PG8_LAS unsigned*)(lds + (bufoff) + ldsw + _i * 8192), 16, 0, 0); } while (0)
#define PG8_LDA(dst, b, h) do { _Pragma("unroll") for (int m = 0; m < 4; ++m) _Pragma("unroll") for (int k = 0; k < 2; ++k) dst[m][k] = *(const PG8_LAS bf16x8*)(lds + PG8_SA(b, h) + aoff + m * 2048 + k * 1024); } while (0)
#define PG8_LDB(dst, b, h) do { _Pragma("unroll") for (int n = 0; n < 2; ++n) _Pragma("unroll") for (int k = 0; k < 2; ++k) dst[n][k] = *(const PG8_LAS bf16x8*)(lds + PG8_SB(b, h) + boff + n * 2048 + k * 1024); } while (0)
#define PG8_MMA(ai, bj, At, Bt) do { __builtin_amdgcn_s_setprio(1); _Pragma("unroll") for (int m = 0; m < 4; ++m) _Pragma("unroll") for (int n = 0; n < 2; ++n) _Pragma("unroll") for (int k = 0; k < 2; ++k) \
        acc[ai][bj][m][n] = __builtin_amdgcn_mfma_f32_16x16x32_bf16(Bt[n][k], At[m][k], acc[ai][bj][m][n], 0, 0, 0); __builtin_amdgcn_s_setprio(0); } while (0)
#define PG8_WAIT_V(n) asm volatile("s_waitcnt vmcnt(" #n ")" ::: "memory")
#define PG8_WAIT_L(n) asm volatile("s_waitcnt lgkmcnt(" #n ")" ::: "memory")
#define PG8_BAR __builtin_amdgcn_s_barrier()
#define PG8_SCHED __builtin_amdgcn_sched_barrier(0)
    Unit cur, nxt; int ui = 0;
    if (!S.next(0, cur)) return;
    f32x4 acc[2][2][4][2];
#pragma unroll
    for (int a = 0; a < 2; ++a)
#pragma unroll
        for (int b = 0; b < 2; ++b)
#pragma unroll
            for (int m = 0; m < 4; ++m)
#pragma unroll
                for (int n = 0; n < 2; ++n) acc[a][b][m][n] = (f32x4){0.f, 0.f, 0.f, 0.f};
    bf16x8 At[4][2], B0[2][2], B1[2][2];
    const char* cA = (const char*)g.A + (size_t)cur.pm * tstepA + (g.kmode == 1 ? (size_t)(cur.pn >> 1) * 512 : g.kmode == 2 ? (size_t)(cur.pn % g.ksl) * (size_t)(K * 2) : (size_t)0); const char* cB = (const char*)g.Bt + (g.kmode == 2 ? (size_t)(cur.pn / g.ksl) * tstepB + (size_t)(cur.pn % g.ksl) * (size_t)(K * 2) : (size_t)cur.pn * tstepB);
    S.a_ready(cur);
    if constexpr (SP2) {
        PG8_STAGE(PG8_SB(0, 0), cB, voffB); PG8_STAGE(PG8_SB(0, 1), cB + hstepB, voffB); PG8_STAGE(PG8_SA(0, 0), cA, voffA); PG8_STAGE(PG8_SA(0, 1), cA + hstepA, voffA);
        if (wr == 1) PG8_BAR;
        PG8_WAIT_V(2); PG8_BAR;
        PG8_STAGE(PG8_SB(1, 0), cB + kstep, voffB); PG8_STAGE(PG8_SA(1, 0), cA + kstep, voffA); PG8_STAGE(PG8_SB(1, 1), cB + hstepB + kstep, voffB);
        PG8_WAIT_V(6); PG8_BAR;
    } else {
        PG8_STAGE(PG8_SB(0, 0), cB, voffB); PG8_STAGE(PG8_SA(0, 0), cA, voffA); PG8_STAGE(PG8_SB(0, 1), cB + hstepB, voffB); PG8_STAGE(PG8_SA(0, 1), cA + hstepA, voffA);
        if (wr == 1) PG8_BAR;
        PG8_WAIT_V(4); PG8_BAR;
        PG8_STAGE(PG8_SB(1, 0), cB + kstep, voffB); PG8_STAGE(PG8_SA(1, 0), cA + kstep, voffA); PG8_STAGE(PG8_SB(1, 1), cB + hstepB + kstep, voffB);
        PG8_WAIT_V(6); PG8_BAR;
    }
    for (;;) {
        const bool has_next = S.next(ui + 1, nxt);
        const char* nA = has_next ? (const char*)g.A + (size_t)nxt.pm * tstepA + (g.kmode == 1 ? (size_t)(nxt.pn >> 1) * 512 : g.kmode == 2 ? (size_t)(nxt.pn % g.ksl) * (size_t)(K * 2) : (size_t)0) : cA; const char* nB = has_next ? (const char*)g.Bt + (g.kmode == 2 ? (size_t)(nxt.pn / g.ksl) * tstepB + (size_t)(nxt.pn % g.ksl) * (size_t)(K * 2) : (size_t)nxt.pn * tstepB) : cB;
        for (int t = 0; t < nt; t += 2) {
            const bool last = (t == nt - 2);
            const char* a1 = cA + (size_t)(t + 1) * kstep;
            const char* a2 = last ? nA : cA + (size_t)(t + 2) * kstep; const char* b2 = last ? nB : cB + (size_t)(t + 2) * kstep;
            const char* a3 = a2 + kstep; const char* b3 = b2 + kstep;
            if (last && has_next) S.a_ready(nxt);
            if constexpr (SP2) {
            PG8_LDB(B0, 0, 0); PG8_LDB(B1, 0, 1); PG8_SCHED; PG8_LDA(At, 0, 0); PG8_STAGE(PG8_SA(1, 1), a1 + hstepA, voffA);
            PG8_WAIT_V(8); PG8_WAIT_L(0); PG8_BAR; PG8_MMA(0, 0, At, B0); PG8_MMA(0, 1, At, B1); PG8_BAR; PG8_SCHED;
            PG8_LDA(At, 0, 1); PG8_STAGE(PG8_SB(0, 0), b2, voffB); PG8_STAGE(PG8_SB(0, 1), b2 + hstepB, voffB); PG8_STAGE(PG8_SA(0, 0), a2, voffA);
            PG8_WAIT_V(8); PG8_WAIT_L(0); PG8_BAR; PG8_MMA(1, 0, At, B0); PG8_MMA(1, 1, At, B1); PG8_BAR; PG8_SCHED;
            PG8_LDB(B0, 1, 0); PG8_LDB(B1, 1, 1); PG8_SCHED; PG8_LDA(At, 1, 0); PG8_STAGE(PG8_SA(0, 1), a2 + hstepA, voffA);
            PG8_WAIT_V(8); PG8_WAIT_L(0); PG8_BAR; PG8_MMA(0, 0, At, B0); PG8_MMA(0, 1, At, B1); PG8_BAR; PG8_SCHED;
            PG8_LDA(At, 1, 1); PG8_STAGE(PG8_SB(1, 0), b3, voffB); PG8_STAGE(PG8_SB(1, 1), b3 + hstepB, voffB); PG8_STAGE(PG8_SA(1, 0), a3, voffA);
            PG8_WAIT_V(8); PG8_WAIT_L(0); PG8_BAR; PG8_MMA(1, 0, At, B0); PG8_MMA(1, 1, At, B1); PG8_BAR; PG8_SCHED;
            } else {
            PG8_LDB(B0, 0, 0); PG8_SCHED; PG8_LDA(At, 0, 0); PG8_STAGE(PG8_SA(1, 1), a1 + hstepA, voffA);
            PG8_WAIT_L(8); PG8_BAR; PG8_WAIT_L(0); PG8_MMA(0, 0, At, B0); PG8_BAR; PG8_SCHED;
            PG8_LDB(B1, 0, 1); PG8_STAGE(PG8_SB(0, 0), b2, voffB);
            PG8_BAR; PG8_WAIT_L(0); PG8_MMA(0, 1, At, B1); PG8_BAR;
            PG8_LDA(At, 0, 1); PG8_STAGE(PG8_SA(0, 0), a2, voffA);
            PG8_BAR; PG8_WAIT_L(0); PG8_MMA(1, 0, At, B0); PG8_BAR; PG8_SCHED;
            PG8_STAGE(PG8_SB(0, 1), b2 + hstepB, voffB);
            PG8_WAIT_V(6); PG8_BAR; PG8_MMA(1, 1, At, B1); PG8_BAR;
            PG8_LDB(B0, 1, 0); PG8_SCHED; PG8_LDA(At, 1, 0); PG8_STAGE(PG8_SA(0, 1), a2 + hstepA, voffA);
            PG8_WAIT_L(8); PG8_BAR; PG8_WAIT_L(0); PG8_MMA(0, 0, At, B0); PG8_BAR; PG8_SCHED;
            PG8_LDB(B1, 1, 1); PG8_STAGE(PG8_SB(1, 0), b3, voffB);
            PG8_BAR; PG8_WAIT_L(0); PG8_MMA(0, 1, At, B1); PG8_BAR;
            PG8_LDA(At, 1, 1); PG8_STAGE(PG8_SA(1, 0), a3, voffA);
            PG8_BAR; PG8_WAIT_L(0); PG8_MMA(1, 0, At, B0); PG8_BAR; PG8_SCHED;
            PG8_STAGE(PG8_SB(1, 1), b3 + hstepB, voffB);
            PG8_WAIT_V(6); PG8_BAR; PG8_MMA(1, 1, At, B1); PG8_BAR;
            }
        }
        if constexpr (ALIGN_EPI) { if (wr == 0) PG8_BAR; }
        if constexpr (!Epi::AFTER_DRAIN) { E(acc, cur, wr, wc, fr, fq); S.done(cur); }
        if (!has_next) break;
#pragma unroll
        for (int a = 0; a < 2; ++a)
#pragma unroll
            for (int b = 0; b < 2; ++b)
#pragma unroll
                for (int m = 0; m < 4; ++m)
#pragma unroll
                    for (int n = 0; n < 2; ++n) acc[a][b][m][n] = (f32x4){0.f, 0.f, 0.f, 0.f};
        cur = nxt; cA = nA; cB = nB; ++ui;
        if constexpr (ALIGN_EPI) { if (wr == 1) PG8_BAR; }
    }
    PG8_WAIT_V(0);
    if constexpr (!ALIGN_EPI) { if (wr == 0) PG8_BAR; }
    PG8_BAR;
    if constexpr (Epi::AFTER_DRAIN) { E.fused(acc, cur, wr, wc, fr, fq, lds, wid, lane); S.done(cur); }
#undef PG8_SA
#undef PG8_SB
#undef PG8_STAGE
#undef PG8_LDA
#undef PG8_LDB
#undef PG8_MMA
#undef PG8_WAIT_V
#undef PG8_WAIT_L
#undef PG8_BAR
#undef PG8_SCHED
}
}


constexpr int D = 1024, DFF = 2816, TP = 2064  , NPR = 8 * TP  , NSM = 512, MR = NPR + NSM  , MP = 17152  ;
constexpr float EPS = 1e-6f;
constexpr int MAINR = 16384  , XROWS = MP - MAINR  ;
constexpr size_t O_YP = 0, O_YS = 16777216, O_RCP = 17301504, O_RHP = 17326080, O_SCP = 17334272, O_RCS = 17350656, O_RHS = 17743872, O_SCS = 17874944;
constexpr size_t MiB = 1u << 20;
constexpr size_t WS_WIN0 = 1 * MiB, WS_WG = 5 * MiB, WS_WOUT0 = 6 * MiB, WS_WSCIN = 8 * MiB, WS_WSCOUT = 14 * MiB, WS_WGU = 16 * MiB, WS_WD = 38 * MiB;
constexpr size_t WS_XMETA = 49 * MiB, WS_STATS = 50 * MiB, WS_AGG = 52 * MiB, WS_HN = 56 * MiB, WS_Y = 90 * MiB, WS_R1 = 124 * MiB, WS_R1B = 158 * MiB, WS_Y2 = 218 * MiB, WS_END = 252 * MiB;
static_assert(WS_HN + (size_t)MP * D * 2 <= WS_Y && WS_Y + (size_t)MP * D * 2 <= WS_R1 && WS_R1 + (size_t)MP * D * 2 <= WS_R1B && WS_R1 + (size_t)MP * DFF * 2 <= WS_Y2 && WS_Y2 + (size_t)MP * D * 2 <= WS_END, "ws map");
constexpr int LDS_BYTES = 135168;

#define GAS __attribute__((address_space(1)))
#define LAS __attribute__((address_space(3)))
typedef unsigned short bf16;
typedef unsigned v4u __attribute__((ext_vector_type(4)));
typedef unsigned v2u __attribute__((ext_vector_type(2)));
typedef float f32x4 __attribute__((ext_vector_type(4)));
typedef float f32x16 __attribute__((ext_vector_type(16)));
typedef short bf16x8 __attribute__((ext_vector_type(8)));

struct Args { const float* in[25]; float* out; unsigned char* ws; };

__device__ __forceinline__ unsigned pk2(float lo, float hi) { return pg8::cvt_pk_bf16(lo, hi); }
__device__ __forceinline__ float bflo(unsigned w) { return __uint_as_float(w << 16); }
__device__ __forceinline__ float bfhi(unsigned w) { return __uint_as_float(w & 0xffff0000u); }
__device__ __forceinline__ float sigmoidf_(float x) { return __builtin_amdgcn_rcpf(1.0f + __expf(-x)); }
__device__ __forceinline__ float gelu_tanh(float x) { const float z = 1.5957691216f * (x + 0.044715f * x * x * x); return x * sigmoidf_(z); }
__device__ __forceinline__ float silu_(float x) { return x * sigmoidf_(x); }
__device__ __forceinline__ float wave_sum(float v) {
#pragma unroll
    for (int o = 1; o < 64; o <<= 1) v += __shfl_xor(v, o);
    return v;
}
#define LDS_WAIT() asm volatile("s_waitcnt lgkmcnt(0)" ::: "memory")

__device__ __forceinline__ void st16_wt(bf16* p, v4u w) { asm volatile("global_store_dwordx4 %0, %1, off sc0 sc1\n\ts_nop 1" :: "v"((GAS v4u*)p), "v"(w) : "memory"); }
__device__ __forceinline__ void st16f_wt(GAS f32x4* p, f32x4 w) { asm volatile("global_store_dwordx4 %0, %1, off sc0 sc1\n\ts_nop 1" :: "v"(p), "v"(w) : "memory"); }
__device__ __forceinline__ void st8_wt(GAS v2u* p, v2u w) { asm volatile("global_store_dwordx2 %0, %1, off sc0 sc1\n\ts_nop 1" :: "v"(p), "v"(w) : "memory"); }
__device__ __forceinline__ void st4_wt(float* p, float v) { asm volatile("global_store_dword %0, %1, off sc0 sc1\n\ts_nop 1" :: "v"((GAS float*)p), "v"(v) : "memory"); }
struct EpiGen {
    static constexpr bool PERM = true, AFTER_DRAIN = false;
    int mode;
    bf16* O0; bf16* O1; float* stats;
    const bf16* XC; const float* pa; const float* pb; const float* pl;
    int ksl;
    __device__ __forceinline__ void operator()(const pg8::f32x4 (&acc)[2][2][4][2], const pg8::Unit& u, int wr, int wc, int fr, int fq) const {
        const int row0 = u.pm * 256 + wr * 64 + fr;
        if (mode == 5) {
            const int ks = u.pn % ksl, pnr = u.pn / ksl;
            bf16* base = O1 + ((size_t)ks * XROWS + (size_t)(row0 - MAINR)) * D + pnr * 256 + wc * 32 + 8 * fq;
#pragma unroll
            for (int ai = 0; ai < 2; ++ai)
#pragma unroll
                for (int m = 0; m < 4; ++m) {
                    bf16* rowp = base + (size_t)(ai * 128 + m * 16) * D;
#pragma unroll
                    for (int bj = 0; bj < 2; ++bj) { const pg8::f32x4 v0 = acc[ai][bj][m][0], v1 = acc[ai][bj][m][1];
                        v4u w; w.x = pk2(v0[0], v0[1]); w.y = pk2(v0[2], v0[3]); w.z = pk2(v1[0], v1[1]); w.w = pk2(v1[2], v1[3]);
                        st16_wt(rowp + bj * 128, w); }
                }
        } else if (mode == 4) {
            const int c0 = 256 * (u.pn >> 1) + 128 * (u.pn & 1) + wc * 32 + 8 * fq;
            float bA[8], bX[8], sp8[8];
            { const f32x4 a0 = *(const GAS f32x4*)(pa + c0), a1 = *(const GAS f32x4*)(pa + c0 + 4), b0 = *(const GAS f32x4*)(pb + c0), b1 = *(const GAS f32x4*)(pb + c0 + 4), l0 = *(const GAS f32x4*)(pl + c0), l1 = *(const GAS f32x4*)(pl + c0 + 4);
#pragma unroll
                for (int i = 0; i < 4; ++i) { bA[i] = a0[i]; bA[4 + i] = a1[i]; bX[i] = b0[i]; bX[4 + i] = b1[i]; sp8[i] = -8.0f * log1pf(__expf(-l0[i])); sp8[4 + i] = -8.0f * log1pf(__expf(-l1[i])); } }
#pragma unroll
            for (int ai = 0; ai < 2; ++ai)
#pragma unroll
                for (int m = 0; m < 4; ++m) {
                    const size_t off = (size_t)(row0 + ai * 128 + m * 16) * D + c0;
                    const v4u xq = *(const GAS v4u*)(XC + off);
                    float xc[8] = {bflo(xq.x), bfhi(xq.x), bflo(xq.y), bfhi(xq.y), bflo(xq.z), bfhi(xq.z), bflo(xq.w), bfhi(xq.w)};
                    float om[8], uu[8];
#pragma unroll
                    for (int n = 0; n < 2; ++n)
#pragma unroll
                        for (int i = 0; i < 4; ++i) { const int e = 4 * n + i;
                            const float r = sigmoidf_(acc[ai][0][m][n][i] + bA[e]), ig = sigmoidf_(acc[ai][1][m][n][i] + bX[e]);
                            const float av = __expf(sp8[e] * r), o1 = 1.0f - av;
                            om[e] = o1; uu[e] = __builtin_amdgcn_sqrtf(fmaxf(o1 * (1.0f + av), 0.f)) * ig * xc[e]; }
                    v4u w; w.x = pk2(om[0], om[1]); w.y = pk2(om[2], om[3]); w.z = pk2(om[4], om[5]); w.w = pk2(om[6], om[7]);
                    st16_wt(O0 + off, w);
                    w.x = pk2(uu[0], uu[1]); w.y = pk2(uu[2], uu[3]); w.z = pk2(uu[4], uu[5]); w.w = pk2(uu[6], uu[7]);
                    st16_wt(O1 + off, w);
                }
        } else if (mode == 3) {
            bf16* base = O0 + (size_t)row0 * D + u.pn * 256 + wc * 32 + 8 * fq;
#pragma unroll
            for (int ai = 0; ai < 2; ++ai)
#pragma unroll
                for (int m = 0; m < 4; ++m) {
                    bf16* rowp = base + (size_t)(ai * 128 + m * 16) * D; float ss = 0.f;
#pragma unroll
                    for (int bj = 0; bj < 2; ++bj) { const pg8::f32x4 v0 = acc[ai][bj][m][0], v1 = acc[ai][bj][m][1];
                        ss += (v0[0] * v0[0] + v0[1] * v0[1]) + (v0[2] * v0[2] + v0[3] * v0[3]) + (v1[0] * v1[0] + v1[1] * v1[1]) + (v1[2] * v1[2] + v1[3] * v1[3]);
                        v4u w; w.x = pk2(v0[0], v0[1]); w.y = pk2(v0[2], v0[3]); w.z = pk2(v1[0], v1[1]); w.w = pk2(v1[2], v1[3]);
                        st16_wt(rowp + bj * 128, w); }
                    ss += __shfl_xor(ss, 16); ss += __shfl_xor(ss, 32);
                    if (fq == 0) st4_wt(stats + (size_t)(row0 + ai * 128 + m * 16) * 16 + u.pn * 4 + wc, ss);
                }
        } else if (mode == 1 || (mode == 2 && u.pn >= 4)) {
            const int ldc = (mode == 1) ? DFF : D; const int q = (mode == 1) ? u.pn : (u.pn - 4);
            bf16* base = (mode == 1 ? O0 : O1) + (size_t)row0 * ldc + q * 128 + wc * 32 + 8 * fq;
#pragma unroll
            for (int ai = 0; ai < 2; ++ai)
#pragma unroll
                for (int m = 0; m < 4; ++m) {
                    pg8::f32x4 g0 = acc[ai][0][m][0], g1 = acc[ai][0][m][1]; const pg8::f32x4 u0 = acc[ai][1][m][0], u1 = acc[ai][1][m][1];
                    if (mode == 1) {
#pragma unroll
                        for (int i = 0; i < 4; ++i) { g0[i] = silu_(g0[i]); g1[i] = silu_(g1[i]); } }
                    g0 = g0 * u0; g1 = g1 * u1;
                    v4u w; w.x = pk2(g0[0], g0[1]); w.y = pk2(g0[2], g0[3]); w.z = pk2(g1[0], g1[1]); w.w = pk2(g1[2], g1[3]);
                    st16_wt(base + (size_t)(ai * 128 + m * 16) * ldc, w);
                }
        } else {
            const bool act = (mode == 0 && u.pn < 4);
            bf16* base = (u.pn < 4 ? O0 : O1) + (size_t)row0 * D + (u.pn & 3) * 256 + wc * 32 + 8 * fq;
#pragma unroll
            for (int ai = 0; ai < 2; ++ai)
#pragma unroll
                for (int m = 0; m < 4; ++m) {
                    bf16* rowp = base + (size_t)(ai * 128 + m * 16) * D;
#pragma unroll
                    for (int bj = 0; bj < 2; ++bj) { pg8::f32x4 v0 = acc[ai][bj][m][0], v1 = acc[ai][bj][m][1];
                        if (act) {
#pragma unroll
                            for (int i = 0; i < 4; ++i) { v0[i] = gelu_tanh(v0[i]); v1[i] = gelu_tanh(v1[i]); } }
                        v4u w; w.x = pk2(v0[0], v0[1]); w.y = pk2(v0[2], v0[3]); w.z = pk2(v1[0], v1[1]); w.w = pk2(v1[2], v1[3]);
                        st16_wt(rowp + bj * 128, w); }
                }
        }
    }
};

__device__ __forceinline__ float* xrow(const Args& a, int r) {
    if (r < NPR) { const int b = r / TP, t = r - b * TP;
        if (t < 16) return (float*)(a.ws + WS_XMETA) + (size_t)(b * 16 + t) * D;
        return a.out + O_YP + (size_t)(b * 2048 + (t - 16)) * D; }
    return a.out + O_YS + (size_t)(r - NPR) * D;
}
__device__ __forceinline__ const float* xsrc(const Args& a, int r) {
    if (r < NPR) { const int b = r / TP, t = r - b * TP;
        if (t < 16) return a.in[5] + (size_t)t * D;
        return a.in[0] + (size_t)(b * 2048 + (t - 16)) * D; }
    return a.in[1] + (size_t)(r - NPR) * D;
}

__device__ __forceinline__ int rowmap(int kind, int n) {
    if (kind == 0) return n;
    if (kind == 1) return 256 * (n >> 7) + (n & 127);
    if (kind == 2) return 256 * (n >> 7) + 128 + (n & 127);
    if (n < 1024) return n;
    if (n < 2048) { const int c = n - 1024; return 1024 + 256 * (c >> 7) + (c & 127); }
    { const int c = n - 2048; return 1024 + 256 * (c >> 7) + 128 + (c & 127); }
}
__device__ __forceinline__ void transpose_item(const float* W, int K, int N, bf16* WT, int kind, LAS float* scr, int item, int lane) {
    const int nblk = N / 32, kb = item / nblk, nb = item - kb * nblk, k0 = 64 * kb, n0 = 32 * nb;
    const GAS float* Wg = (const GAS float*)W;
#pragma unroll 8
    for (int i = 0; i < 32; ++i) { const int kk = 2 * i + (lane >> 5); scr[kk * 33 + (lane & 31)] = Wg[(size_t)(k0 + kk) * N + n0 + (lane & 31)]; }
    LDS_WAIT(); asm volatile("" ::: "memory");
    const int c = lane & 7; const int rb = rowmap(kind, n0);
#pragma unroll
    for (int j = 0; j < 4; ++j) { const int n = (lane >> 3) + 8 * j; const LAS float* s = scr + (8 * c) * 33 + n;
        v4u o; o.x = pk2(s[0 * 33], s[1 * 33]); o.y = pk2(s[2 * 33], s[3 * 33]); o.z = pk2(s[4 * 33], s[5 * 33]); o.w = pk2(s[6 * 33], s[7 * 33]);
        *(GAS v4u*)(WT + (size_t)(rb + n) * K + k0 + 8 * c) = o; }
    LDS_WAIT(); asm volatile("" ::: "memory");
}
constexpr int I_IN0 = 16 * 64, I_G = 4 * 8, I_O = 16 * 32, I_SC = 16 * 96, I_GU = 16 * 88, I_DN = 44 * 32;
constexpr int NITEMS = I_IN0 + 8 * I_G + 2 * I_O + I_SC + 4 * I_GU + 2 * I_DN, NITEMS_A = I_IN0 + 8 * I_G;
__device__ __forceinline__ void p0_item(const Args& a, LAS float* scr, int it, int lane) {
    unsigned char* ws = a.ws;
    do {
        int r = it;
        if (r < I_IN0) { transpose_item(a.in[10], 1024, 2048, (bf16*)(ws + WS_WIN0), 0, scr, r, lane); continue; } r -= I_IN0;
        if (r < 8 * I_G) { const int m = r / I_G, h = m & 3, gx = m >> 2;
            transpose_item(a.in[gx ? 15 : 13] + (size_t)h * 65536, 256, 256, (bf16*)(ws + WS_WG) + (size_t)h * 131072, gx ? 2 : 1, scr, r - m * I_G, lane); continue; } r -= 8 * I_G;
        if (r < I_O) { transpose_item(a.in[18], 1024, 1024, (bf16*)(ws + WS_WOUT0), 0, scr, r, lane); continue; } r -= I_O;
        if (r < I_SC) { transpose_item(a.in[19], 1024, 3072, (bf16*)(ws + WS_WSCIN), 3, scr, r, lane); continue; } r -= I_SC;
        if (r < I_O) { transpose_item(a.in[21], 1024, 1024, (bf16*)(ws + WS_WSCOUT), 0, scr, r, lane); continue; } r -= I_O;
        if (r < 4 * I_GU) { const int m = r / I_GU, l = m & 1, up = m >> 1;
            transpose_item(a.in[up ? 23 : 22] + (size_t)l * 1024 * DFF, 1024, DFF, (bf16*)(ws + WS_WGU) + (size_t)l * 5632 * 1024, up ? 2 : 1, scr, r - m * I_GU, lane); continue; } r -= 4 * I_GU;
        { const int l = r / I_DN; transpose_item(a.in[24] + (size_t)l * DFF * 1024, DFF, 1024, (bf16*)(ws + WS_WD) + (size_t)l * 1024 * DFF, 0, scr, r - l * I_DN, lane); }
    } while (0);
}
__device__ __forceinline__ void p0_phase(const Args& a, LAS unsigned char* lds, int wave, int lane) {
    { int t_ = lane_id(); asm volatile("" : "+v"(t_)); lane = t_; }
    LAS float* scr = (LAS float*)(lds + wave * 16384);
    const int gw = blockIdx.x * 8 + wave, NGW = gridDim.x * 8;
    unsigned char* ws = a.ws;
    for (int it = gw; it < NITEMS_A; it += NGW) p0_item(a, scr, it, lane);
    const GAS f32x4* wq = (const GAS f32x4*)a.in[6] + lane;
    f32x4 wpre[4];
#pragma unroll
    for (int j = 0; j < 4; ++j) wpre[j] = wq[64 * j];
    bf16* HN = (bf16*)(ws + WS_HN);
    for (int r0 = gw; r0 < MR; r0 += 2 * NGW) {
        f32x4 v[2][4]; float ss[2] = {0.f, 0.f};
#pragma unroll
        for (int u = 0; u < 2; ++u) { const int r = (r0 + u * NGW < MR) ? r0 + u * NGW : r0; const GAS f32x4* xs = (const GAS f32x4*)xsrc(a, r) + lane;
#pragma unroll
            for (int j = 0; j < 4; ++j) v[u][j] = xs[64 * j]; }
#pragma unroll
        for (int u = 0; u < 2; ++u) {
#pragma unroll
            for (int j = 0; j < 4; ++j) ss[u] += (v[u][j].x * v[u][j].x + v[u][j].y * v[u][j].y) + (v[u][j].z * v[u][j].z + v[u][j].w * v[u][j].w);
            const float rs = rsqrtf(wave_sum(ss[u]) * (1.0f / D) + EPS);
            const int r = r0 + u * NGW;
            if (r < MR) { GAS v2u* o8 = (GAS v2u*)(HN + (size_t)r * D) + lane;
#pragma unroll
                for (int j = 0; j < 4; ++j) { const f32x4 h = v[u][j] * rs * wpre[j]; v2u o; o.x = pk2(h.x, h.y); o.y = pk2(h.z, h.w); o8[64 * j] = o; } }
        }
    }
}

constexpr int CW_CNT = 4096, CW_BANK = 8192, CW_Q = CW_CNT + 14 * CW_BANK, CTL_WORDS = CW_Q + 8 * 64;
__device__ __forceinline__ unsigned ld_rlx(unsigned* p) { return __hip_atomic_load(p, __ATOMIC_RELAXED, __HIP_MEMORY_SCOPE_AGENT); }
struct PubOrder : pg8::StaticOrder {
    unsigned* cnt;
    __device__ __forceinline__ void done(const pg8::Unit& u) const {
        asm volatile("s_waitcnt vmcnt(0)" ::: "memory");
        if (lane_id() == 0) __hip_atomic_fetch_add(cnt + 64 * u.pm, 1u, __ATOMIC_RELAXED, __HIP_MEMORY_SCOPE_AGENT);
    }
};
struct ExtraOrder : PubOrder {
    int ksl;
    __device__ __forceinline__ bool next(int i, pg8::Unit& u) const { const int L = i * G + c; if (L >= 12 * ksl) return false; u.pm = 64 + L / (4 * ksl); u.pn = L % (4 * ksl); return true; }
};
struct CountedOrder : pg8::StaticOrder {
    unsigned* gready; unsigned gneed;
    unsigned* ready; unsigned need, need66; int wv;
    unsigned* gcnt;
    unsigned* cnt;
    __device__ __forceinline__ void a_ready(const pg8::Unit& u) const {
        if (wv == 0) {
            const unsigned nd = (u.pm < 66) ? need : need66;
            unsigned sp = 0;
            while ((unsigned)__builtin_amdgcn_readfirstlane(__hip_atomic_load(ready + 64 * u.pm, __ATOMIC_RELAXED, __HIP_MEMORY_SCOPE_AGENT)) < nd) { __builtin_amdgcn_s_sleep(2); if (++sp > (1u << 18)) break; }
            if (gready) { while ((unsigned)__builtin_amdgcn_readfirstlane(__hip_atomic_load(gready, __ATOMIC_RELAXED, __HIP_MEMORY_SCOPE_AGENT)) < gneed) { __builtin_amdgcn_s_sleep(2); if (++sp > (1u << 18)) break; } }
            __builtin_amdgcn_fence(__ATOMIC_ACQUIRE, "agent");
            asm volatile("s_waitcnt vmcnt(0)" ::: "memory");
        }
        asm volatile("" ::: "memory"); __builtin_amdgcn_s_barrier(); asm volatile("" ::: "memory");
    }
    __device__ __forceinline__ void done(const pg8::Unit& u) const {
        if (cnt) { asm volatile("s_waitcnt vmcnt(0)" ::: "memory");
            if (lane_id() == 0) { __hip_atomic_fetch_add(cnt + 64 * u.pm, 1u, __ATOMIC_RELAXED, __HIP_MEMORY_SCOPE_AGENT); if (gcnt) __hip_atomic_fetch_add(gcnt, 1u, __ATOMIC_RELAXED, __HIP_MEMORY_SCOPE_AGENT); } }
    }
};
struct ExtraOrderC : CountedOrder {
    int ksl;
    __device__ __forceinline__ bool next(int i, pg8::Unit& u) const { const int L = i * G + c; if (L >= 12 * ksl) return false; u.pm = 64 + L / (4 * ksl); u.pn = L % (4 * ksl); return true; }
};
#define TAIL_BEGIN(BANK, NCHUNKS, NEED, PLO_EXPR, PHI_EXPR) \
    for (;;) { __syncthreads(); \
        if (wave == 0 && lane_id() == 0) { const unsigned c_ = __hip_atomic_fetch_add(ctl + CW_Q + 64 * (BANK), 1u, __ATOMIC_RELAXED, __HIP_MEMORY_SCOPE_AGENT); \
            if (c_ < (unsigned)(NCHUNKS)) { const int chunk = (int)c_; const int plo_ = (PLO_EXPR), phi_ = (PHI_EXPR); \
                for (int p_ = plo_; p_ <= phi_; ++p_) { unsigned sp_ = 0; while (ld_rlx(ctl + CW_CNT + (BANK) * CW_BANK + 64 * p_) < (unsigned)(NEED)) { __builtin_amdgcn_s_sleep(2); if (++sp_ > (1u << 18)) break; } } \
                __builtin_amdgcn_fence(__ATOMIC_ACQUIRE, "agent"); asm volatile("s_waitcnt vmcnt(0)" ::: "memory"); } \
            *bc = c_; } \
        __syncthreads(); \
        const unsigned cu_ = *bc; if (cu_ >= (unsigned)(NCHUNKS)) break; const int chunk = (int)cu_;
#define TAIL_END }
#define TAIL_BEGIN_PUB(BANK, PUBBANK, NCHUNKS, NEED, PLO_EXPR, PHI_EXPR) \
    int prevp_ = -1; \
    for (;;) { __syncthreads(); \
        if (wave == 0 && lane_id() == 0) { \
            if (prevp_ >= 0) { __hip_atomic_fetch_add(ctl + CW_CNT + (PUBBANK) * CW_BANK + 64 * prevp_, 1u, __ATOMIC_RELAXED, __HIP_MEMORY_SCOPE_AGENT); \
                               __hip_atomic_fetch_add(ctl + CW_CNT + (PUBBANK) * CW_BANK + 64 * 100, 1u, __ATOMIC_RELAXED, __HIP_MEMORY_SCOPE_AGENT); } \
            const unsigned c_ = __hip_atomic_fetch_add(ctl + CW_Q + 64 * (BANK), 1u, __ATOMIC_RELAXED, __HIP_MEMORY_SCOPE_AGENT); \
            if (c_ < (unsigned)(NCHUNKS)) { const int chunk = (int)c_; const int plo_ = (PLO_EXPR), phi_ = (PHI_EXPR); \
                for (int p_ = plo_; p_ <= phi_; ++p_) { unsigned sp_ = 0; while (ld_rlx(ctl + CW_CNT + (BANK) * CW_BANK + 64 * p_) < (unsigned)(NEED)) { __builtin_amdgcn_s_sleep(2); if (++sp_ > (1u << 18)) break; } } \
                __builtin_amdgcn_fence(__ATOMIC_ACQUIRE, "agent"); asm volatile("s_waitcnt vmcnt(0)" ::: "memory"); } \
            *bc = c_; } \
        __syncthreads(); \
        const unsigned cu_ = *bc; if (cu_ >= (unsigned)(NCHUNKS)) break; const int chunk = (int)cu_; prevp_ = (PHI_EXPR);

__device__ __forceinline__ void p0b_tail(const Args& a, LAS unsigned char* lds, int wave, int lane, unsigned* ctl, volatile LAS unsigned* bc) {
    { int t_ = lane_id(); asm volatile("" : "+v"(t_)); lane = t_; }
    LAS float* scr = (LAS float*)(lds + wave * 16384);
    constexpr int NCH = (NITEMS - NITEMS_A + 7) / 8;
    for (;;) { __syncthreads();
        if (wave == 0 && lane_id() == 0) *bc = __hip_atomic_fetch_add(ctl + CW_Q + 64 * 7, 1u, __ATOMIC_RELAXED, __HIP_MEMORY_SCOPE_AGENT);
        __syncthreads();
        const unsigned c = *bc; if (c >= (unsigned)NCH) break;
        const int it = NITEMS_A + 8 * (int)c + wave;
        if (it < NITEMS) p0_item(a, scr, it, lane);
    }
}
template <bool FIRST, int XS, int PUB>
__device__ __forceinline__ void norm_res_tail(const Args& a, const float* wpost_, const float* wpre_, int wave, int lane, unsigned* ctl, int bank, volatile LAS unsigned* bc) {
    { int t_ = lane_id(); asm volatile("" : "+v"(t_)); lane = t_; }
    const GAS f32x4* wp4 = (const GAS f32x4*)wpost_ + lane;
    f32x4 wpost[4], wpre[4];
#pragma unroll
    for (int j = 0; j < 4; ++j) { wpost[j] = wp4[64 * j]; wpre[j] = wpre_ ? ((const GAS f32x4*)wpre_ + lane)[64 * j] : (f32x4){0.f, 0.f, 0.f, 0.f}; }
    const GAS float* stats = (const GAS float*)(a.ws + WS_STATS);
    const bf16* Y = (const bf16*)(a.ws + WS_Y); const bf16* PX = (const bf16*)(a.ws + WS_Y2); bf16* HN = (bf16*)(a.ws + WS_HN);
    int prev_panel = -1;
    for (;;) { __syncthreads();
        if (wave == 0 && lane_id() == 0) {
            if (PUB >= 0 && prev_panel >= 0) __hip_atomic_fetch_add(ctl + CW_CNT + (PUB >= 0 ? PUB : 0) * CW_BANK + 64 * prev_panel, 1u, __ATOMIC_RELAXED, __HIP_MEMORY_SCOPE_AGENT);
            const unsigned c_ = __hip_atomic_fetch_add(ctl + CW_Q + 64 * bank, 1u, __ATOMIC_RELAXED, __HIP_MEMORY_SCOPE_AGENT);
            if (c_ < (unsigned)(MR / 32)) { const int p_ = (int)c_ >> 3; unsigned sp_ = 0;
                while (ld_rlx(ctl + CW_CNT + bank * CW_BANK + 64 * p_) < (unsigned)(p_ < 64 ? 32 : 32 * XS)) { __builtin_amdgcn_s_sleep(2); if (++sp_ > (1u << 18)) break; }
                __builtin_amdgcn_fence(__ATOMIC_ACQUIRE, "agent"); asm volatile("s_waitcnt vmcnt(0)" ::: "memory"); }
            *bc = c_; }
        __syncthreads();
        const unsigned cu_ = *bc; if (cu_ >= (unsigned)(MR / 32)) break; const int chunk = (int)cu_; prev_panel = chunk >> 3;
    if (chunk * 32 < MAINR) {
#pragma unroll
    for (int k = 0; k < 4; ++k) {
        const int r = chunk * 32 + wave * 4 + k;
        GAS f32x4* xp = (GAS f32x4*)xrow(a, r) + lane; const GAS f32x4* xs = (const GAS f32x4*)xsrc(a, r) + lane;
        GAS v2u* xb = (GAS v2u*)((GAS bf16*)xrow(a, r) + D) + lane;
        const GAS v2u* yp = (const GAS v2u*)(Y + (size_t)r * D) + lane;
        float s = (!false && lane < 16) ? stats[(size_t)r * 16 + lane] : 0.f;
        f32x4 v[4], yf[4]; v2u yy[4], y2[4];
#pragma unroll
        for (int j = 0; j < 4; ++j) { if (FIRST) v[j] = xs[64 * j]; else { const v2u q = xb[64 * j]; v[j] = (f32x4){bflo(q.x), bfhi(q.x), bflo(q.y), bfhi(q.y)}; } yy[j] = false ? (v2u){0u, 0u} : yp[64 * j]; }
#pragma unroll
        for (int j = 0; j < 4; ++j) { f32x4 y; y.x = bflo(yy[j].x); y.y = bfhi(yy[j].x); y.z = bflo(yy[j].y); y.w = bfhi(yy[j].y); yf[j] = y; }
        if (false) {
            v2u pq[XS][4];
#pragma unroll
            for (int sl = 0; sl < XS; ++sl) { const GAS v2u* pp = (const GAS v2u*)(PX + ((size_t)sl * XROWS + (size_t)(r - MAINR)) * D) + lane;
#pragma unroll
                for (int j = 0; j < 4; ++j) pq[sl][j] = pp[64 * j]; }
#pragma unroll
            for (int sl = 0; sl < XS; ++sl)
#pragma unroll
                for (int j = 0; j < 4; ++j) { yf[j].x += bflo(pq[sl][j].x); yf[j].y += bfhi(pq[sl][j].x); yf[j].z += bflo(pq[sl][j].y); yf[j].w += bfhi(pq[sl][j].y); }
#pragma unroll
            for (int j = 0; j < 4; ++j) s += (yf[j].x * yf[j].x + yf[j].y * yf[j].y) + (yf[j].z * yf[j].z + yf[j].w * yf[j].w);
        }
        const float rs = rsqrtf(wave_sum(s) * (1.0f / D) + EPS);
        float ss = 0.f;
#pragma unroll
        for (int j = 0; j < 4; ++j) { const f32x4 y = yf[j];
            v[j] = v[j] + y * rs * wpost[j]; if (wpre_) { v2u q; q.x = pk2(v[j].x, v[j].y); q.y = pk2(v[j].z, v[j].w); if (PUB >= 0) st8_wt(xb + 64 * j, q); else xb[64 * j] = q; } else xp[64 * j] = v[j];
            ss += (v[j].x * v[j].x + v[j].y * v[j].y) + (v[j].z * v[j].z + v[j].w * v[j].w); }
        if (wpre_) {
            const float rs1 = rsqrtf(wave_sum(ss) * (1.0f / D) + EPS);
            GAS v2u* o8 = (GAS v2u*)(HN + (size_t)r * D) + lane;
#pragma unroll
            for (int j = 0; j < 4; ++j) { const f32x4 h = v[j] * rs1 * wpre[j]; v2u o; o.x = pk2(h.x, h.y); o.y = pk2(h.z, h.w); if (PUB >= 0) st8_wt(o8 + 64 * j, o); else o8[64 * j] = o; }
        }
    }
    } else {
#pragma unroll 2
    for (int k = 0; k < 4; ++k) {
        const int r = chunk * 32 + wave * 4 + k;
        GAS f32x4* xp = (GAS f32x4*)xrow(a, r) + lane; const GAS f32x4* xs = (const GAS f32x4*)xsrc(a, r) + lane;
        GAS v2u* xb = (GAS v2u*)((GAS bf16*)xrow(a, r) + D) + lane;
        const GAS v2u* yp = (const GAS v2u*)(Y + (size_t)r * D) + lane;
        float s = (!true && lane < 16) ? stats[(size_t)r * 16 + lane] : 0.f;
        f32x4 v[4], yf[4]; v2u yy[4], y2[4];
#pragma unroll
        for (int j = 0; j < 4; ++j) { if (FIRST) v[j] = xs[64 * j]; else { const v2u q = xb[64 * j]; v[j] = (f32x4){bflo(q.x), bfhi(q.x), bflo(q.y), bfhi(q.y)}; } yy[j] = true ? (v2u){0u, 0u} : yp[64 * j]; }
#pragma unroll
        for (int j = 0; j < 4; ++j) { f32x4 y; y.x = bflo(yy[j].x); y.y = bfhi(yy[j].x); y.z = bflo(yy[j].y); y.w = bfhi(yy[j].y); yf[j] = y; }
        if (true) {
            v2u pq[XS][4];
#pragma unroll
            for (int sl = 0; sl < XS; ++sl) { const GAS v2u* pp = (const GAS v2u*)(PX + ((size_t)sl * XROWS + (size_t)(r - MAINR)) * D) + lane;
#pragma unroll
                for (int j = 0; j < 4; ++j) pq[sl][j] = pp[64 * j]; }
#pragma unroll
            for (int sl = 0; sl < XS; ++sl)
#pragma unroll
                for (int j = 0; j < 4; ++j) { yf[j].x += bflo(pq[sl][j].x); yf[j].y += bfhi(pq[sl][j].x); yf[j].z += bflo(pq[sl][j].y); yf[j].w += bfhi(pq[sl][j].y); }
#pragma unroll
            for (int j = 0; j < 4; ++j) s += (yf[j].x * yf[j].x + yf[j].y * yf[j].y) + (yf[j].z * yf[j].z + yf[j].w * yf[j].w);
        }
        const float rs = rsqrtf(wave_sum(s) * (1.0f / D) + EPS);
        float ss = 0.f;
#pragma unroll
        for (int j = 0; j < 4; ++j) { const f32x4 y = yf[j];
            v[j] = v[j] + y * rs * wpost[j]; if (wpre_) { v2u q; q.x = pk2(v[j].x, v[j].y); q.y = pk2(v[j].z, v[j].w); if (PUB >= 0) st8_wt(xb + 64 * j, q); else xb[64 * j] = q; } else xp[64 * j] = v[j];
            ss += (v[j].x * v[j].x + v[j].y * v[j].y) + (v[j].z * v[j].z + v[j].w * v[j].w); }
        if (wpre_) {
            const float rs1 = rsqrtf(wave_sum(ss) * (1.0f / D) + EPS);
            GAS v2u* o8 = (GAS v2u*)(HN + (size_t)r * D) + lane;
#pragma unroll
            for (int j = 0; j < 4; ++j) { const f32x4 h = v[j] * rs1 * wpre[j]; v2u o; o.x = pk2(h.x, h.y); o.y = pk2(h.z, h.w); if (PUB >= 0) st8_wt(o8 + 64 * j, o); else o8[64 * j] = o; }
        }
    }
    }
    if (PUB >= 0) asm volatile("s_waitcnt vmcnt(0)" ::: "memory");
    TAIL_END
}

__device__ __forceinline__ void rgconv_tail(const Args& a, unsigned* ctl, volatile LAS unsigned* bc, const int wave) {
    int tidx = wave * 64 + lane_id(); asm volatile("" : "+v"(tidx));
    const bf16* XR = (const bf16*)(a.ws + WS_R1B); bf16* XC = (bf16*)(a.ws + WS_HN);
    const GAS float* cw = (const GAS float*)a.in[11]; const GAS float* cb = (const GAS float*)a.in[12]; const GAS float* st = (const GAS float*)a.in[2];
    const int ch0 = 8 * (tidx & 127);
    float w[4][8], bb[8];
#pragma unroll
    for (int k = 0; k < 4; ++k) { const f32x4 w0 = *(const GAS f32x4*)(cw + k * D + ch0), w1 = *(const GAS f32x4*)(cw + k * D + ch0 + 4);
        w[k][0] = w0.x; w[k][1] = w0.y; w[k][2] = w0.z; w[k][3] = w0.w; w[k][4] = w1.x; w[k][5] = w1.y; w[k][6] = w1.z; w[k][7] = w1.w; }
    { const f32x4 b0 = *(const GAS f32x4*)(cb + ch0), b1 = *(const GAS f32x4*)(cb + ch0 + 4);
        bb[0] = b0.x; bb[1] = b0.y; bb[2] = b0.z; bb[3] = b0.w; bb[4] = b1.x; bb[5] = b1.y; bb[6] = b1.z; bb[7] = b1.w; }
    TAIL_BEGIN(0, MR / 32, 64, (chunk > 0 ? (32 * chunk - 3) >> 8 : 0), (32 * chunk) >> 8)
    if (32 * chunk < NPR) {
        const int R0 = 32 * chunk + 8 * (tidx >> 7), bq = R0 / TP, t0 = R0 - bq * TP;
        v4u win[11];
#pragma unroll
        for (int wi = 0; wi < 11; ++wi) win[wi] = (t0 - 3 + wi >= 0) ? *(const GAS v4u*)(XR + (size_t)(R0 - 3 + wi) * D + ch0) : (v4u){0u, 0u, 0u, 0u};
#pragma unroll
        for (int i = 0; i < 8; ++i) {
            float c8[8];
#pragma unroll
            for (int e = 0; e < 8; ++e) c8[e] = bb[e];
#pragma unroll
            for (int k = 0; k < 4; ++k) { const v4u q = win[i + k]; const float x[8] = {bflo(q.x), bfhi(q.x), bflo(q.y), bfhi(q.y), bflo(q.z), bfhi(q.z), bflo(q.w), bfhi(q.w)};
#pragma unroll
                for (int e = 0; e < 8; ++e) c8[e] = fmaf(w[k][e], x[e], c8[e]); }
            if (t0 + i >= TP - 3) { const v4u q = win[i + 3]; const float x[8] = {bflo(q.x), bfhi(q.x), bflo(q.y), bfhi(q.y), bflo(q.z), bfhi(q.z), bflo(q.w), bfhi(q.w)};
                GAS float* dst = (GAS float*)a.out + O_RCP + (size_t)(bq * 3 + (t0 + i - (TP - 3))) * D + ch0;
                *(GAS f32x4*)dst = (f32x4){x[0], x[1], x[2], x[3]}; *(GAS f32x4*)(dst + 4) = (f32x4){x[4], x[5], x[6], x[7]}; }
            v4u o; o.x = pk2(c8[0], c8[1]); o.y = pk2(c8[2], c8[3]); o.z = pk2(c8[4], c8[5]); o.w = pk2(c8[6], c8[7]);
            *(GAS v4u*)(XC + (size_t)(R0 + i) * D + ch0) = o;
        }
    } else
#pragma unroll 4
    for (int i_ = 0; i_ < 8; ++i_) {
        const int R = 32 * chunk + (tidx >> 7) + 4 * i_;
        int t, T, bq; const bool is_sample = (R >= NPR);
        if (!is_sample) { bq = R / TP; t = R - bq * TP; T = TP; } else { bq = (R - NPR) >> 2; t = (R - NPR) & 3; T = 4; }
        float c8[8];
#pragma unroll
        for (int e = 0; e < 8; ++e) c8[e] = bb[e];
#pragma unroll
        for (int k = 0; k < 4; ++k) {
            const int tt = t - 3 + k; float x[8];
            if (tt >= 0) { const v4u q = *(const GAS v4u*)(XR + (size_t)(R - 3 + k) * D + ch0);
                x[0] = bflo(q.x); x[1] = bfhi(q.x); x[2] = bflo(q.y); x[3] = bfhi(q.y); x[4] = bflo(q.z); x[5] = bfhi(q.z); x[6] = bflo(q.w); x[7] = bfhi(q.w); }
            else if (is_sample) { const GAS float* sp = st + (size_t)(bq * 3 + (3 + tt)) * D + ch0; const f32x4 q0 = *(const GAS f32x4*)sp, q1 = *(const GAS f32x4*)(sp + 4);
                x[0] = q0.x; x[1] = q0.y; x[2] = q0.z; x[3] = q0.w; x[4] = q1.x; x[5] = q1.y; x[6] = q1.z; x[7] = q1.w; }
            else {
#pragma unroll
                for (int e = 0; e < 8; ++e) x[e] = 0.f; }
#pragma unroll
            for (int e = 0; e < 8; ++e) c8[e] = fmaf(w[k][e], x[e], c8[e]);
            if (k == 3 && t >= T - 3) {
                GAS float* dst = (GAS float*)a.out + (is_sample ? O_RCS : O_RCP) + (size_t)(bq * 3 + (t - (T - 3))) * D + ch0;
                *(GAS f32x4*)dst = (f32x4){x[0], x[1], x[2], x[3]}; *(GAS f32x4*)(dst + 4) = (f32x4){x[4], x[5], x[6], x[7]};
            }
        }
        v4u o; o.x = pk2(c8[0], c8[1]); o.y = pk2(c8[2], c8[3]); o.z = pk2(c8[4], c8[5]); o.w = pk2(c8[6], c8[7]);
        *(GAS v4u*)(XC + (size_t)R * D + ch0) = o;
    }
    TAIL_END
}

__device__ __forceinline__ bool seq_start(int R) { return R < NPR ? (R % TP == 0) : (((R - NPR) & 3) == 0); }
__device__ __forceinline__ bool seq_end(int R) { return R < NPR ? (R % TP == TP - 1) : (((R - NPR) & 3) == 3); }
template <int PASS>
__device__ __forceinline__ void lru_scan_item(const Args& a, LAS unsigned char* lds, const int j, const int q, const int wave, unsigned* ctl = nullptr) {
    int tid_ = wave * 64 + lane_id(); asm volatile("" : "+v"(tid_));
    const int tid = tid_, sub = tid >> 5, oct = tid & 31;
    const bf16* OMA = (const bf16*)(a.ws + WS_Y); const bf16* U = (const bf16*)(a.ws + WS_R1B); const bf16* GG = (const bf16*)(a.ws + WS_R1); bf16* A2 = (bf16*)(a.ws + WS_HN);
    GAS float* AGG = (GAS float*)(a.ws + WS_AGG); const GAS float* sth = (const GAS float*)a.in[3];
    LAS float* sagg = (LAS float*)lds;
    {
        const int ch0 = 256 * q + 8 * oct, Rb = 64 * j + 4 * sub;
        v4u qa[4], qu[4], gq[4];
#pragma unroll
        for (int rr = 0; rr < 4; ++rr) { qa[rr] = *(const GAS v4u*)(OMA + (size_t)(Rb + rr) * D + ch0); qu[rr] = *(const GAS v4u*)(U + (size_t)(Rb + rr) * D + ch0);
            if (PASS == 2) gq[rr] = *(const GAS v4u*)(GG + (size_t)(Rb + rr) * D + ch0); }
        float av[4][8], uv[4][8], h0[4][8];
#pragma unroll
        for (int rr = 0; rr < 4; ++rr) {
            av[rr][0] = 1.f - bflo(qa[rr].x); av[rr][1] = 1.f - bfhi(qa[rr].x); av[rr][2] = 1.f - bflo(qa[rr].y); av[rr][3] = 1.f - bfhi(qa[rr].y);
            av[rr][4] = 1.f - bflo(qa[rr].z); av[rr][5] = 1.f - bfhi(qa[rr].z); av[rr][6] = 1.f - bflo(qa[rr].w); av[rr][7] = 1.f - bfhi(qa[rr].w);
            uv[rr][0] = bflo(qu[rr].x); uv[rr][1] = bfhi(qu[rr].x); uv[rr][2] = bflo(qu[rr].y); uv[rr][3] = bfhi(qu[rr].y);
            uv[rr][4] = bflo(qu[rr].z); uv[rr][5] = bfhi(qu[rr].z); uv[rr][6] = bflo(qu[rr].w); uv[rr][7] = bfhi(qu[rr].w);
            const int R = Rb + rr;
            if (R >= NPR && ((R - NPR) & 3) == 0) { const GAS float* hp = sth + (size_t)((R - NPR) >> 2) * D + ch0; const f32x4 p0 = *(const GAS f32x4*)hp, p1 = *(const GAS f32x4*)(hp + 4);
                h0[rr][0] = p0.x; h0[rr][1] = p0.y; h0[rr][2] = p0.z; h0[rr][3] = p0.w; h0[rr][4] = p1.x; h0[rr][5] = p1.y; h0[rr][6] = p1.z; h0[rr][7] = p1.w; }
            else {
#pragma unroll
                for (int e = 0; e < 8; ++e) h0[rr][e] = 0.f; }
        }
        const bool lookback = (PASS == 2) && (64 * j < NPR);
        if (lookback) {
            const int jt0 = (((64 * j) / TP) * TP) >> 6, n = j - jt0;
            float SA[8], SH[8];
#pragma unroll
            for (int e = 0; e < 8; ++e) { SA[e] = 1.f; SH[e] = 0.f; }
            f32x4 ev[3][4];
#pragma unroll
            for (int k = 0; k < 3; ++k) { const int idx = 3 * sub + k; const GAS f32x4* src = (const GAS f32x4*)(AGG + ((size_t)(jt0 + (idx < n ? idx : 0)) * D + ch0) * 2);
#pragma unroll
                for (int e = 0; e < 4; ++e) ev[k][e] = src[e]; }
#pragma unroll
            for (int k = 0; k < 3; ++k) if (3 * sub + k < n) {
#pragma unroll
                for (int e = 0; e < 4; ++e) { const f32x4 v = ev[k][e]; SH[2 * e] = fmaf(v.x, SH[2 * e], v.y); SA[2 * e] *= v.x; SH[2 * e + 1] = fmaf(v.z, SH[2 * e + 1], v.w); SA[2 * e + 1] *= v.z; } }
            LAS f32x4* dst = (LAS f32x4*)(sagg + 8192 + (size_t)(sub * 256 + 8 * oct) * 2);
#pragma unroll
            for (int e = 0; e < 4; ++e) dst[e] = (f32x4){SA[2 * e], SH[2 * e], SA[2 * e + 1], SH[2 * e + 1]};
        }
        float A8[8], H8[8];
#pragma unroll
        for (int e = 0; e < 8; ++e) { A8[e] = 1.f; H8[e] = 0.f; }
#pragma unroll
        for (int rr = 0; rr < 4; ++rr) { const bool st = seq_start(Rb + rr);
#pragma unroll
            for (int e = 0; e < 8; ++e) { const float hp = st ? h0[rr][e] : H8[e]; H8[e] = fmaf(av[rr][e], hp, uv[rr][e]); A8[e] = st ? 0.f : A8[e] * av[rr][e]; } }
        { LAS f32x4* dst = (LAS f32x4*)(sagg + (size_t)(sub * 256 + 8 * oct) * 2);
#pragma unroll
            for (int e = 0; e < 4; ++e) dst[e] = (f32x4){A8[2 * e], H8[2 * e], A8[2 * e + 1], H8[2 * e + 1]}; }
        __syncthreads();
        if (PASS == 1) {
            if (tid < 32) {
                float A[8], H[8];
#pragma unroll
                for (int e = 0; e < 8; ++e) { A[e] = 1.f; H[e] = 0.f; }
#pragma unroll 4
                for (int s = 0; s < 16; ++s) { const LAS f32x4* src = (const LAS f32x4*)(sagg + (size_t)(s * 256 + 8 * oct) * 2);
#pragma unroll
                    for (int e = 0; e < 4; ++e) { const f32x4 v = src[e]; H[2 * e] = fmaf(v.x, H[2 * e], v.y); A[2 * e] *= v.x; H[2 * e + 1] = fmaf(v.z, H[2 * e + 1], v.w); A[2 * e + 1] *= v.z; } }
                GAS f32x4* dst = (GAS f32x4*)(AGG + ((size_t)j * D + ch0) * 2);
#pragma unroll
                for (int e = 0; e < 4; ++e) st16f_wt(dst + e, (f32x4){A[2 * e], H[2 * e], A[2 * e + 1], H[2 * e + 1]});
                asm volatile("s_waitcnt vmcnt(0)" ::: "memory");
            }
        } else {
            float C8[8];
#pragma unroll
            for (int e = 0; e < 8; ++e) C8[e] = 0.f;
            if (lookback) {
                LAS float* tcar = sagg + 16384;
                if (tid < 32) {
#pragma unroll 4
                    for (int sg = 0; sg < 16; ++sg) { const LAS f32x4* src = (const LAS f32x4*)(sagg + 8192 + (size_t)(sg * 256 + 8 * oct) * 2);
#pragma unroll
                        for (int e = 0; e < 4; ++e) { const f32x4 v = src[e]; C8[2 * e] = fmaf(v.x, C8[2 * e], v.y); C8[2 * e + 1] = fmaf(v.z, C8[2 * e + 1], v.w); } }
                    *(LAS f32x4*)(tcar + 8 * oct) = (f32x4){C8[0], C8[1], C8[2], C8[3]}; *(LAS f32x4*)(tcar + 8 * oct + 4) = (f32x4){C8[4], C8[5], C8[6], C8[7]};
                }
                __syncthreads();
                const f32x4 c0 = *(const LAS f32x4*)(tcar + 8 * oct), c1 = *(const LAS f32x4*)(tcar + 8 * oct + 4);
                C8[0] = c0.x; C8[1] = c0.y; C8[2] = c0.z; C8[3] = c0.w; C8[4] = c1.x; C8[5] = c1.y; C8[6] = c1.z; C8[7] = c1.w;
            }
            for (int s = 0; s < sub; ++s) { const LAS f32x4* src = (const LAS f32x4*)(sagg + (size_t)(s * 256 + 8 * oct) * 2);
#pragma unroll
                for (int e = 0; e < 4; ++e) { const f32x4 v = src[e]; C8[2 * e] = fmaf(v.x, C8[2 * e], v.y); C8[2 * e + 1] = fmaf(v.z, C8[2 * e + 1], v.w); } }
#pragma unroll
            for (int rr = 0; rr < 4; ++rr) { const int R = Rb + rr; const bool st = seq_start(R);
                const v4u g = gq[rr];
#pragma unroll
                for (int e = 0; e < 8; ++e) { const float hp = st ? h0[rr][e] : C8[e]; C8[e] = fmaf(av[rr][e], hp, uv[rr][e]); }
                v4u o; o.x = pk2(C8[0] * bflo(g.x), C8[1] * bfhi(g.x)); o.y = pk2(C8[2] * bflo(g.y), C8[3] * bfhi(g.y));
                o.z = pk2(C8[4] * bflo(g.z), C8[5] * bfhi(g.z)); o.w = pk2(C8[6] * bflo(g.w), C8[7] * bfhi(g.w));
                st16_wt(A2 + (size_t)R * D + ch0, o);
                if (seq_end(R)) { GAS float* dst = (GAS float*)a.out + (R < NPR ? O_RHP + (size_t)(R / TP) * D : O_RHS + (size_t)((R - NPR) >> 2) * D) + ch0;
                    *(GAS f32x4*)dst = (f32x4){C8[0], C8[1], C8[2], C8[3]}; *(GAS f32x4*)(dst + 4) = (f32x4){C8[4], C8[5], C8[6], C8[7]}; }
            }
            asm volatile("s_waitcnt vmcnt(0)" ::: "memory");
        }
        __syncthreads();
        if (PASS == 2 && wave == 0 && lane_id() == 0) {
            __hip_atomic_fetch_add(ctl + CW_CNT + 12 * CW_BANK + 64 * (j >> 2), 1u, __ATOMIC_RELAXED, __HIP_MEMORY_SCOPE_AGENT);
            __hip_atomic_fetch_add(ctl + CW_CNT + 12 * CW_BANK + 64 * 100, 1u, __ATOMIC_RELAXED, __HIP_MEMORY_SCOPE_AGENT); }
    }
}

__device__ __forceinline__ void lru_scan1_tail(const Args& a, LAS unsigned char* lds, unsigned* ctl, volatile LAS unsigned* bc, const int wave) {
    TAIL_BEGIN(1, 266 * 2, 64, chunk >> 3, chunk >> 3)
    lru_scan_item<1>(a, lds, chunk >> 1, 2 * (chunk & 1), wave); lru_scan_item<1>(a, lds, chunk >> 1, 2 * (chunk & 1) + 1, wave);
    if (wave == 0 && lane_id() == 0) __hip_atomic_fetch_add(ctl + CW_CNT + 13 * CW_BANK + 16 * (chunk >> 1), 1u, __ATOMIC_RELAXED, __HIP_MEMORY_SCOPE_AGENT);
    TAIL_END
}
__device__ __forceinline__ void lru_scan2_phase(const Args& a, LAS unsigned char* lds, const int wave, unsigned* ctl) {
#pragma unroll 1
    for (int it = blockIdx.x; it < 266 * 4; it += gridDim.x) {
        const int j = it >> 2;
        if (wave == 0) {
            const int jt0 = (64 * j < NPR) ? ((((64 * j) / TP) * TP) >> 6) : j, n = j - jt0, l = lane_id();
            unsigned* w = (l < n) ? ctl + CW_CNT + 13 * CW_BANK + 16 * (jt0 + l) : ctl + CW_CNT + 1 * CW_BANK + 64 * (j >> 2);
            const unsigned nd = (l < n) ? 2u : (l == n ? 64u : 0u);
            unsigned sp = 0;
            while (!__all(__hip_atomic_load(w, __ATOMIC_RELAXED, __HIP_MEMORY_SCOPE_AGENT) >= nd)) { __builtin_amdgcn_s_sleep(2); if (++sp > (1u << 18)) break; }
            __builtin_amdgcn_fence(__ATOMIC_ACQUIRE, "agent"); asm volatile("s_waitcnt vmcnt(0)" ::: "memory");
        }
        __syncthreads();
        lru_scan_item<2>(a, lds, j, it & 3, wave, ctl);
    }
}

__device__ __forceinline__ void sconv_tail(const Args& a, unsigned* ctl, volatile LAS unsigned* bc, const int wave) {
    int tidx = wave * 64 + lane_id(); asm volatile("" : "+v"(tidx));
    const bf16* BG = (const bf16*)(a.ws + WS_R1); const bf16* CV = (const bf16*)(a.ws + WS_R1B); bf16* A3 = (bf16*)(a.ws + WS_HN);
    const GAS float* cw = (const GAS float*)a.in[20]; const GAS float* st = (const GAS float*)a.in[4];
    const int ch0 = 8 * (tidx & 127);
    float w[3][8];
#pragma unroll
    for (int k = 0; k < 3; ++k) { const f32x4 w0 = *(const GAS f32x4*)(cw + k * D + ch0), w1 = *(const GAS f32x4*)(cw + k * D + ch0 + 4);
        w[k][0] = w0.x; w[k][1] = w0.y; w[k][2] = w0.z; w[k][3] = w0.w; w[k][4] = w1.x; w[k][5] = w1.y; w[k][6] = w1.z; w[k][7] = w1.w; }
    TAIL_BEGIN_PUB(4, 10, MR / 32, 96, (chunk > 0 ? (32 * chunk - 2) >> 8 : 0), (32 * chunk) >> 8)
    if (32 * chunk < NPR) {
        const int R0 = 32 * chunk + 8 * (tidx >> 7), bq = R0 / TP, t0 = R0 - bq * TP;
        v4u win[10], bgq[8];
#pragma unroll
        for (int wi = 0; wi < 10; ++wi) win[wi] = (t0 - 2 + wi >= 0) ? *(const GAS v4u*)(CV + (size_t)(R0 - 2 + wi) * D + ch0) : (v4u){0u, 0u, 0u, 0u};
#pragma unroll
        for (int i = 0; i < 8; ++i) bgq[i] = *(const GAS v4u*)(BG + (size_t)(R0 + i) * D + ch0);
#pragma unroll
        for (int i = 0; i < 8; ++i) {
            float c8[8];
#pragma unroll
            for (int e = 0; e < 8; ++e) c8[e] = 0.f;
#pragma unroll
            for (int k = 0; k < 3; ++k) { const v4u q = win[i + k]; const float x[8] = {bflo(q.x), bfhi(q.x), bflo(q.y), bfhi(q.y), bflo(q.z), bfhi(q.z), bflo(q.w), bfhi(q.w)};
#pragma unroll
                for (int e = 0; e < 8; ++e) c8[e] = fmaf(w[k][e], x[e], c8[e]); }
            if (t0 + i >= TP - 2) { const v4u q = win[i + 2]; const float x[8] = {bflo(q.x), bfhi(q.x), bflo(q.y), bfhi(q.y), bflo(q.z), bfhi(q.z), bflo(q.w), bfhi(q.w)};
                GAS float* dst = (GAS float*)a.out + O_SCP + (size_t)(bq * 2 + (t0 + i - (TP - 2))) * D + ch0;
                *(GAS f32x4*)dst = (f32x4){x[0], x[1], x[2], x[3]}; *(GAS f32x4*)(dst + 4) = (f32x4){x[4], x[5], x[6], x[7]}; }
            const v4u g = bgq[i];
            v4u o; o.x = pk2(bflo(g.x) * c8[0], bfhi(g.x) * c8[1]); o.y = pk2(bflo(g.y) * c8[2], bfhi(g.y) * c8[3]);
            o.z = pk2(bflo(g.z) * c8[4], bfhi(g.z) * c8[5]); o.w = pk2(bflo(g.w) * c8[6], bfhi(g.w) * c8[7]);
            st16_wt(A3 + (size_t)(R0 + i) * D + ch0, o);
        }
    } else
#pragma unroll 4
    for (int i_ = 0; i_ < 8; ++i_) {
        const int R = 32 * chunk + (tidx >> 7) + 4 * i_;
        int t, T, bq; const bool is_sample = (R >= NPR);
        if (!is_sample) { bq = R / TP; t = R - bq * TP; T = TP; } else { bq = (R - NPR) >> 2; t = (R - NPR) & 3; T = 4; }
        float c8[8];
#pragma unroll
        for (int e = 0; e < 8; ++e) c8[e] = 0.f;
#pragma unroll
        for (int k = 0; k < 3; ++k) {
            const int tt = t - 2 + k; float x[8];
            if (tt >= 0) { const v4u q = *(const GAS v4u*)(CV + (size_t)(R - 2 + k) * D + ch0);
                x[0] = bflo(q.x); x[1] = bfhi(q.x); x[2] = bflo(q.y); x[3] = bfhi(q.y); x[4] = bflo(q.z); x[5] = bfhi(q.z); x[6] = bflo(q.w); x[7] = bfhi(q.w); }
            else if (is_sample) { const GAS float* sp = st + (size_t)(bq * 2 + (2 + tt)) * D + ch0; const f32x4 q0 = *(const GAS f32x4*)sp, q1 = *(const GAS f32x4*)(sp + 4);
                x[0] = q0.x; x[1] = q0.y; x[2] = q0.z; x[3] = q0.w; x[4] = q1.x; x[5] = q1.y; x[6] = q1.z; x[7] = q1.w; }
            else {
#pragma unroll
                for (int e = 0; e < 8; ++e) x[e] = 0.f; }
#pragma unroll
            for (int e = 0; e < 8; ++e) c8[e] = fmaf(w[k][e], x[e], c8[e]);
            if (k == 2 && t >= T - 2) {
                GAS float* dst = (GAS float*)a.out + (is_sample ? O_SCS : O_SCP) + (size_t)(bq * 2 + (t - (T - 2))) * D + ch0;
                *(GAS f32x4*)dst = (f32x4){x[0], x[1], x[2], x[3]}; *(GAS f32x4*)(dst + 4) = (f32x4){x[4], x[5], x[6], x[7]};
            }
        }
        const v4u g = *(const GAS v4u*)(BG + (size_t)R * D + ch0);
        v4u o; o.x = pk2(bflo(g.x) * c8[0], bfhi(g.x) * c8[1]); o.y = pk2(bflo(g.y) * c8[2], bfhi(g.y) * c8[3]);
        o.z = pk2(bflo(g.z) * c8[4], bfhi(g.z) * c8[5]); o.w = pk2(bflo(g.w) * c8[6], bfhi(g.w) * c8[7]);
        st16_wt(A3 + (size_t)R * D + ch0, o);
    }
    asm volatile("s_waitcnt vmcnt(0)" ::: "memory");
    TAIL_END
}

#define XB_TMO      128
#define XB_XCNT(j)  (256  + 64 * (j))
#define XB_XSUB(j)  (1280 + 64 * (j))
#define XB_XGEN(j)  (2304 + 64 * (j))
#define XB_TOP      3328
#define XB_TOPGEN   3392
#define XCD_BAR_WORDS 3456
#define XB_SPIN_CAP (1u << 18)

__device__ __forceinline__ unsigned xb_ld(unsigned* p)              { return __hip_atomic_load(p, __ATOMIC_RELAXED, __HIP_MEMORY_SCOPE_AGENT); }
__device__ __forceinline__ unsigned xb_add(unsigned* p, unsigned v) { return __hip_atomic_fetch_add(p, v, __ATOMIC_RELAXED, __HIP_MEMORY_SCOPE_AGENT); }
__device__ __forceinline__ unsigned xb_xcc_id() { return (unsigned)__builtin_amdgcn_s_getreg((3 << 11) | 20) & 0xFu; }
#define XB_SPIN(cond, bar) do { unsigned _sp = 0; while (cond) { __builtin_amdgcn_s_sleep(1); \
    if ((++_sp & 255u) == 0u) { if (xb_ld(&(bar)[XB_TMO])) break; if (_sp > XB_SPIN_CAP) { atomicAdd(&(bar)[XB_TMO], 1u); break; } } } } while (0)

struct XcdBarrier {
    unsigned* bar; unsigned x;
    volatile LAS unsigned* st;
};

__device__ __forceinline__ XcdBarrier xcd_barrier_post(unsigned* bar, volatile LAS unsigned* st, const int wave) {
    XcdBarrier b; b.bar = bar; b.x = xb_xcc_id(); b.st = st;
    if (wave == 0 && lane_id() == 0) (void)xb_add(&bar[XB_XCNT(b.x)], 1u);
    return b;
}
__device__ __forceinline__ void xcd_barrier_complete(unsigned* bar, unsigned x, unsigned& nloc, unsigned& nx) {
    const unsigned G = gridDim.x * gridDim.y * gridDim.z;
    unsigned sum, cnt, mine, sp = 0u;
    for (;;) {
        sum = 0u; cnt = 0u; mine = 0u;
#pragma unroll
        for (unsigned j = 0; j < 16; ++j) { const unsigned c = xb_ld(&bar[XB_XCNT(j)]); sum += c; cnt += (c > 0u) ? 1u : 0u; mine = (j == x) ? c : mine; }
        if (sum == G) break;
        __builtin_amdgcn_s_sleep(1);
        if ((++sp & 255u) == 0u) { if (xb_ld(&bar[XB_TMO])) break; if (sp > XB_SPIN_CAP) { atomicAdd(&bar[XB_TMO], 1u); break; } }
    }
    nloc = mine > 0u ? mine : 1u; nx = cnt > 0u ? cnt : 1u;
}

__device__ __forceinline__ void xcd_barrier(const XcdBarrier& b, const int wave) {
    asm volatile("s_waitcnt vmcnt(0)" ::: "memory");
    __syncthreads();
    if (wave == 0 && lane_id() == 0) {
        unsigned* bar = b.bar;
        __builtin_amdgcn_s_waitcnt(0);
        unsigned nloc = b.st[0], nx = b.st[1];
        if (nloc == 0u) { xcd_barrier_complete(bar, b.x, nloc, nx); b.st[0] = nloc; b.st[1] = nx; }
        const unsigned old = xb_add(&bar[XB_XSUB(b.x)], 1u);
        const unsigned gen = old / nloc;
        if (old + 1u == (gen + 1u) * nloc) {
            __builtin_amdgcn_fence(__ATOMIC_RELEASE, "agent");
            asm volatile("s_waitcnt vmcnt(0)" ::: "memory");
            const unsigned og = xb_add(&bar[XB_TOP], 1u);
            const unsigned tg = og / nx;
            if (og + 1u == (tg + 1u) * nx) xb_add(&bar[XB_TOPGEN], 1u);
            else XB_SPIN(xb_ld(&bar[XB_TOPGEN]) == tg, bar);
            __builtin_amdgcn_fence(__ATOMIC_ACQUIRE, "agent");
            xb_add(&bar[XB_XGEN(b.x)], 1u);
            asm volatile("s_waitcnt vmcnt(0)" ::: "memory");
        } else {
            XB_SPIN(xb_ld(&bar[XB_XGEN(b.x)]) == gen, bar);
            __builtin_amdgcn_fence(__ATOMIC_ACQUIRE, "agent");
            asm volatile("s_waitcnt vmcnt(0)" ::: "memory");
        }
    }
    __syncthreads();
}

__global__ void __launch_bounds__(512, 2) fwd_kernel(Args a) {
    extern __shared__ __attribute__((aligned(16))) unsigned char lds_raw[];
    LAS unsigned char* lds = (LAS unsigned char*)lds_raw;
    cg::grid_group grid = cg::this_grid();
    const int wave = __builtin_amdgcn_readfirstlane((int)threadIdx.x >> 6), lane = lane_id(), tid = wave * 64 + lane;
    unsigned char* ws = a.ws;
    bf16* HN = (bf16*)(ws + WS_HN); bf16* Y = (bf16*)(ws + WS_Y); bf16* R1 = (bf16*)(ws + WS_R1); bf16* R1B = (bf16*)(ws + WS_R1B);
    float* STATS = (float*)(ws + WS_STATS);
#define GEMM_STEP(BANK, Aptr, Bptr, NN, KK, MODE, OUT0, OUT1) GEMM_STEP_M(BANK, MP, Aptr, Bptr, NN, KK, MODE, OUT0, OUT1)
#define GEMM_STEP_M(BANK, MROWS, Aptr, Bptr, NN, KK, MODE, OUT0, OUT1) do { pg8::Gemm g; g.A = (Aptr); g.Bt = (Bptr); g.M = (MROWS); g.N = (NN); g.K = (KK); g.lda = (KK); g.ldb = (KK); g.kmode = 0; g.ksl = 1; \
        EpiGen E; E.mode = (MODE); E.O0 = (OUT0); E.O1 = (OUT1); E.stats = STATS; E.XC = nullptr; E.pa = nullptr; E.pb = nullptr; E.pl = nullptr; E.ksl = 1; \
        PubOrder S; S.init((MROWS), (NN), (int)gridDim.x, (int)blockIdx.x, (BANK) == 7 ? 8 : 1); S.cnt = ctl + CW_CNT + (BANK) * CW_BANK; \
        if ((BANK) == 7) pg8::gemm_phase<EpiGen, pg8::StaticOrder, true, true>(lds, g, S, E, wave); else pg8::gemm_phase<EpiGen, PubOrder, true, true>(lds, g, S, E, wave); } while (0)
    volatile LAS unsigned* st = (volatile LAS unsigned*)(lds + 131072 + 64);
    if (tid < 2) st[tid] = 0u;
    unsigned* barw = (unsigned*)ws;
    unsigned* ctl = (unsigned*)ws;
    volatile LAS unsigned* bc = (volatile LAS unsigned*)(lds + 131072 + 128);
#define GU_STEP(RBANK, Bptr, GREADY, GNEED) do { pg8::Gemm g; g.A = HN; g.Bt = (Bptr); g.M = MP; g.N = 5632; g.K = 1024; g.lda = 1024; g.ldb = 1024; g.kmode = 0; g.ksl = 1; \
        EpiGen E; E.mode = 1; E.O0 = R1; E.O1 = nullptr; E.stats = STATS; E.XC = nullptr; E.pa = nullptr; E.pb = nullptr; E.pl = nullptr; E.ksl = 1; \
        CountedOrder S; S.init(MP, 5632, (int)gridDim.x, (int)blockIdx.x, 4); S.ready = ctl + CW_CNT + (RBANK) * CW_BANK; S.need = 8u; S.need66 = 4u; S.gready = (GREADY); S.gneed = (GNEED); S.wv = wave; S.gcnt = nullptr; S.cnt = ctl + CW_CNT + 7 * CW_BANK; \
        pg8::gemm_phase<EpiGen, CountedOrder, true, true>(lds, g, S, E, wave); } while (0)

#define DOWNM_STEP(BANK, Bptr, GUNEED, GCNT) do { pg8::Gemm g; g.A = R1; g.Bt = (Bptr); g.M = MAINR; g.N = 1024; g.K = DFF; g.lda = DFF; g.ldb = DFF; g.kmode = 0; g.ksl = 1; \
        EpiGen E; E.mode = 3; E.O0 = Y; E.O1 = nullptr; E.stats = STATS; E.XC = nullptr; E.pa = nullptr; E.pb = nullptr; E.pl = nullptr; E.ksl = 1; \
        CountedOrder S; S.init(MAINR, 1024, (int)gridDim.x, (int)blockIdx.x, 1); S.ready = ctl + CW_CNT + 7 * CW_BANK; S.need = (GUNEED); S.need66 = (GUNEED); S.gready = nullptr; S.gneed = 0u; S.wv = wave; S.gcnt = (GCNT); S.cnt = ctl + CW_CNT + (BANK) * CW_BANK; \
        pg8::gemm_phase<EpiGen, CountedOrder, true, true>(lds, g, S, E, wave); } while (0)
#define DOWNX_STEP(BANK, Bptr, GUNEED, GCNT) do { int kx_ = 256; asm volatile("" : "+s"(kx_)); \
        pg8::Gemm g; g.A = R1; g.Bt = (Bptr); g.M = MP; g.N = 1024; g.K = kx_; g.lda = DFF; g.ldb = DFF; g.kmode = 2; g.ksl = 11; \
        EpiGen E; E.mode = 5; E.O0 = Y; E.O1 = (bf16*)(ws + WS_Y2); E.stats = STATS; E.XC = nullptr; E.pa = nullptr; E.pb = nullptr; E.pl = nullptr; E.ksl = 11; \
        ExtraOrderC S; S.init(MP, 1024, (int)gridDim.x, (int)blockIdx.x, 1); S.ready = ctl + CW_CNT + 7 * CW_BANK; S.need = (GUNEED); S.need66 = (GUNEED); S.gready = nullptr; S.gneed = 0u; S.wv = wave; S.gcnt = (GCNT); S.cnt = ctl + CW_CNT + (BANK) * CW_BANK; S.ksl = 11; \
        pg8::gemm_phase<EpiGen, ExtraOrderC, true, true>(lds, g, S, E, wave); } while (0)
#define OUT_STEP(BANK, Bptr, RBANK, NEEDP, NEED66P) do { { pg8::Gemm g; g.A = HN; g.Bt = (Bptr); g.M = MAINR; g.N = 1024; g.K = 1024; g.lda = 1024; g.ldb = 1024; g.kmode = 0; g.ksl = 1; \
        EpiGen E; E.mode = 3; E.O0 = Y; E.O1 = nullptr; E.stats = STATS; E.XC = nullptr; E.pa = nullptr; E.pb = nullptr; E.pl = nullptr; E.ksl = 1; \
        CountedOrder S; S.init(MAINR, 1024, (int)gridDim.x, (int)blockIdx.x, 1); S.ready = ctl + CW_CNT + (RBANK) * CW_BANK; S.need = (NEEDP); S.need66 = (NEED66P); S.gready = nullptr; S.gneed = 0u; S.wv = wave; S.gcnt = nullptr; S.cnt = ctl + CW_CNT + (BANK) * CW_BANK; \
        pg8::gemm_phase<EpiGen, CountedOrder, true, true>(lds, g, S, E, wave); } \
      { int kx_ = 256; asm volatile("" : "+s"(kx_)); \
        pg8::Gemm g; g.A = HN; g.Bt = (Bptr); g.M = MP; g.N = 1024; g.K = kx_; g.lda = 1024; g.ldb = 1024; g.kmode = 2; g.ksl = 4; \
        EpiGen E; E.mode = 5; E.O0 = Y; E.O1 = (bf16*)(ws + WS_Y2); E.stats = STATS; E.XC = nullptr; E.pa = nullptr; E.pb = nullptr; E.pl = nullptr; E.ksl = 4; \
        ExtraOrderC S; S.init(MP, 1024, (int)gridDim.x, (int)blockIdx.x, 1); S.ready = ctl + CW_CNT + (RBANK) * CW_BANK; S.need = (NEEDP); S.need66 = (NEED66P); S.gready = nullptr; S.gneed = 0u; S.wv = wave; S.gcnt = nullptr; S.cnt = ctl + CW_CNT + (BANK) * CW_BANK; S.ksl = 4; \
        pg8::gemm_phase<EpiGen, ExtraOrderC, true, true>(lds, g, S, E, wave); } } while (0)
#define EXTRA_STEP(BANK, Aptr, Bptr, KTOT, NSL) do { int kx_ = 256; asm volatile("" : "+s"(kx_));     \
        pg8::Gemm g; g.A = (Aptr); g.Bt = (Bptr); g.M = MP; g.N = 1024; g.K = kx_; g.lda = (KTOT); g.ldb = (KTOT); g.kmode = 2; g.ksl = (NSL); \
        EpiGen E; E.mode = 5; E.O0 = Y; E.O1 = (bf16*)(ws + WS_Y2); E.stats = STATS; E.XC = nullptr; E.pa = nullptr; E.pb = nullptr; E.pl = nullptr; E.ksl = (NSL); \
        ExtraOrder S; S.init(MP, 1024, (int)gridDim.x, (int)blockIdx.x, 1); S.cnt = ctl + CW_CNT + (BANK) * CW_BANK; S.ksl = (NSL); \
        pg8::gemm_phase<EpiGen, ExtraOrder, true, true>(lds, g, S, E, wave); } while (0)
    __syncthreads();
    XcdBarrier bar = xcd_barrier_post(barw, st, wave);
#define GSYNC() xcd_barrier(bar, wave)
    if (a.ws == nullptr) grid.sync();
    p0_phase(a, lds, wave, lane); GSYNC();
    GEMM_STEP(0, HN, (const bf16*)(ws + WS_WIN0), 2048, 1024, 0, R1, R1B);
    rgconv_tail(a, ctl, bc, wave); p0b_tail(a, lds, wave, lane, ctl, bc); GSYNC();
    { pg8::Gemm g; g.A = HN; g.Bt = (const bf16*)(ws + WS_WG); g.M = MP; g.N = 2048; g.K = 256; g.lda = 1024; g.ldb = 256; g.kmode = 1; g.ksl = 1;
      EpiGen E; E.mode = 4; E.O0 = Y; E.O1 = R1B; E.stats = STATS; E.ksl = 1; E.XC = HN; E.pa = a.in[14]; E.pb = a.in[16]; E.pl = a.in[17];
      PubOrder S; S.init(MP, 2048, (int)gridDim.x, (int)blockIdx.x, 1); S.cnt = ctl + CW_CNT + 1 * CW_BANK;
      pg8::gemm_phase<EpiGen, PubOrder, true, true>(lds, g, S, E, wave); }
    lru_scan1_tail(a, lds, ctl, bc, wave);
    lru_scan2_phase(a, lds, wave, ctl);
    OUT_STEP(2, (const bf16*)(ws + WS_WOUT0), 12, 16u, 8u);
    norm_res_tail<true, 4, 8>(a, a.in[7], a.in[8], wave, lane, ctl, 2, bc);
    GU_STEP(8, (const bf16*)(ws + WS_WGU), ctl + CW_CNT + 12 * CW_BANK + 64 * 100, 1064u);
    DOWNM_STEP(3, (const bf16*)(ws + WS_WD), 176u, ctl + CW_CNT + 3 * CW_BANK + 64 * 100); DOWNX_STEP(3, (const bf16*)(ws + WS_WD), 176u, ctl + CW_CNT + 3 * CW_BANK + 64 * 100);
    norm_res_tail<false, 11, 11>(a, a.in[9], a.in[6] + D, wave, lane, ctl, 3, bc);
    { pg8::Gemm g; g.A = HN; g.Bt = (const bf16*)(ws + WS_WSCIN); g.M = MP; g.N = 3072; g.K = 1024; g.lda = 1024; g.ldb = 1024; g.kmode = 0; g.ksl = 1;
      EpiGen E; E.mode = 2; E.O0 = R1; E.O1 = R1B; E.stats = STATS; E.XC = nullptr; E.pa = nullptr; E.pb = nullptr; E.pl = nullptr; E.ksl = 1;
      CountedOrder S; S.init(MP, 3072, (int)gridDim.x, (int)blockIdx.x, 1); S.ready = ctl + CW_CNT + 11 * CW_BANK; S.need = 8u; S.need66 = 4u;
      S.gready = ctl + CW_CNT + 3 * CW_BANK + 64 * 100; S.gneed = (256u + 132u) * 8u;
      S.wv = wave; S.gcnt = nullptr; S.cnt = ctl + CW_CNT + 4 * CW_BANK;
      pg8::gemm_phase<EpiGen, CountedOrder, true, true>(lds, g, S, E, wave); }
    sconv_tail(a, ctl, bc, wave);
    OUT_STEP(5, (const bf16*)(ws + WS_WSCOUT), 10, 8u, 4u);
    norm_res_tail<false, 4, 9>(a, a.in[7] + D, a.in[8] + D, wave, lane, ctl, 5, bc);
    GU_STEP(9, (const bf16*)(ws + WS_WGU) + (size_t)5632 * 1024, ctl + CW_CNT + 10 * CW_BANK + 64 * 100, 532u);
    DOWNM_STEP(6, (const bf16*)(ws + WS_WD) + (size_t)1024 * DFF, 352u, nullptr); DOWNX_STEP(6, (const bf16*)(ws + WS_WD) + (size_t)1024 * DFF, 352u, nullptr);
    norm_res_tail<false, 11, -1>(a, a.in[9] + D, nullptr, wave, lane, ctl, 6, bc);
}

extern "C" void kernel_launch(void* const* d_in, const int* in_sizes, int n_in, void* d_out, int out_size, void* d_ws, size_t ws_size, hipStream_t stream) {
    static int grid = 0;
    if (grid == 0) {
        if (n_in != 25 || ws_size < WS_END) { fprintf(stderr, "kernel_launch: unexpected n_in %d / ws_size %zu\n", n_in, ws_size); grid = -1; return; }
        int dev = 0, cus = 0, per_cu = 0;
        hipGetDevice(&dev);
        hipDeviceGetAttribute(&cus, hipDeviceAttributeMultiprocessorCount, dev);
        if (hipFuncSetAttribute((const void*)fwd_kernel, hipFuncAttributeMaxDynamicSharedMemorySize, LDS_BYTES) != hipSuccess) { fprintf(stderr, "kernel_launch: hipFuncSetAttribute failed\n"); grid = -1; return; }
        if (hipOccupancyMaxActiveBlocksPerMultiprocessor(&per_cu, (const void*)fwd_kernel, 512, LDS_BYTES) != hipSuccess || per_cu < 1) { fprintf(stderr, "kernel_launch: occupancy query failed (%d)\n", per_cu); (void)hipGetLastError(); per_cu = 1; }
        grid = cus * per_cu;
        fprintf(stderr, "kernel_launch: %d CUs x %d = grid %d\n", cus, per_cu, grid);
    }
    if (grid < 0) return;
    Args a{};
    for (int i = 0; i < 25; ++i) a.in[i] = (const float*)d_in[i];
    a.out = (float*)d_out; a.ws = (unsigned char*)d_ws;
    if (hipMemsetAsync(d_ws, 0, (size_t)CTL_WORDS * 4, stream) != hipSuccess) { fprintf(stderr, "kernel_launch: memset failed\n"); return; }
    void* args[] = {&a};
    hipError_t e = hipLaunchCooperativeKernel((const void*)fwd_kernel, dim3(grid), dim3(512), args, LDS_BYTES, stream);
    if (e != hipSuccess) fprintf(stderr, "kernel_launch: cooperative launch failed: %s (grid %d)\n", hipGetErrorString(e), grid);
}
```

```cpp
#include <hip/hip_runtime.h>
#include <hip/hip_cooperative_groups.h>
#include <cstdio>
#include <cstdint>
namespace cg = cooperative_groups;
__device__ __forceinline__ int lane_id() { return (int)__builtin_amdgcn_mbcnt_hi(~0u, __builtin_amdgcn_mbcnt_lo(~0u, 0u)); }

namespace pg8 {
#define PG8_LAS __attribute__((address_space(3)))
typedef unsigned short bf16_t;
typedef short bf16x8 __attribute__((ext_vector_type(8)));
typedef float f32x4 __attribute__((ext_vector_type(4)));
typedef unsigned u32x4 __attribute__((ext_vector_type(4)));
constexpr int BM = 256, BK = 64, HALF = 128, HTB = HALF * BK * 2  , STAGE_BYTES = 8 * HTB, NXCD = 8, WGM = 8;

__host__ __device__ __forceinline__ int lds_byte(int r, int c) { const int st = (r >> 4) * 2 + (c >> 5), rr = r & 15, cc = c & 31, ob = rr * 64 + cc * 2; return st * 1024 + (ob ^ (((ob >> 9) & 1) << 5)); }
__host__ __device__ __forceinline__ void stage_rc(int b, int& R, int& C) { const int st = b / 1024, sb = b % 1024, swz = sb ^ (((sb >> 9) & 1) << 5); R = (st >> 1) * 16 + swz / 64; C = (st & 1) * 32 + (swz % 64) / 2; }
__host__ __device__ __forceinline__ int perm32(int rho) { const int n = rho >> 4, i = rho & 15; return 8 * (i >> 2) + 4 * n + (i & 3); }

struct Unit { int pm, pn; };
struct Gemm { const bf16_t* A; const bf16_t* Bt; int M, N, K, lda, ldb, kmode, ksl; };

struct StaticOrder {
    int nM, nN, nwg, G, c, wgm;
    __host__ __device__ void init(int M, int N, int G_, int c_, int wgm_ = WGM) { nM = M / BM; nN = N / BM; nwg = nM * nN; G = G_; c = c_; wgm = wgm_; }
    __host__ __device__ bool next(int i, Unit& u) const {
        const long L = (long)i * G + c; if (L >= nwg) return false;
        int wgid = (int)L; { const int q = nwg / NXCD, r = nwg % NXCD, xcd = wgid % NXCD, off = wgid / NXCD; wgid = (xcd < r ? xcd * (q + 1) : r * (q + 1) + (xcd - r) * q) + off; }
        const int nig = wgm * nN, gid = wgid / nig, fm = gid * wgm, gsz = (nM - fm) < wgm ? (nM - fm) : wgm;
        u.pm = fm + ((wgid % nig) % gsz); u.pn = (wgid % nig) / gsz; return true;
    }
    __device__ __forceinline__ void a_ready(const Unit&) const {}
    __device__ __forceinline__ void done(const Unit&) const {}
};

__device__ __forceinline__ unsigned cvt_pk_bf16(float lo, float hi) { unsigned r; asm volatile("v_cvt_pk_bf16_f32 %0, %1, %2" : "=v"(r) : "v"(lo), "v"(hi)); return r; }

template <class Epi, class Sched, bool ALIGN_EPI = false, bool SP2 = false>
__device__ __forceinline__ void gemm_phase(PG8_LAS unsigned char* lds, const Gemm g, const Sched& S, const Epi& E, const int wave_s) {
    int tid_ = wave_s * 64 + lane_id(); asm volatile("" : "+v"(tid_));
    const int tid = tid_, wid = __builtin_amdgcn_readfirstlane(tid >> 6), lane = tid & 63, wr = wid >> 2, wc = wid & 3, fr = lane & 15, fq = lane >> 4;
    const int K = g.K, nt = K / BK;
    unsigned voffA[2], voffB[2];
#pragma unroll
    for (int i = 0; i < 2; ++i) { int R, C; stage_rc(tid * 16 + i * 8192, R, C); const int Rb = Epi::PERM ? ((R & ~31) + perm32(R & 31)) : R;
        voffA[i] = (unsigned)(R * g.lda + C) * 2u; voffB[i] = (unsigned)(Rb * g.ldb + C) * 2u; }
    const size_t kstep = (size_t)(BK * 2);
    const size_t hstepB = (size_t)HALF * g.ldb * 2, hstepA = (size_t)HALF * g.lda * 2;
    const size_t tstepB = 2 * hstepB, tstepA = 2 * hstepA;
    const unsigned ldsw = (unsigned)wid * 1024u;
    const int aoff = lds_byte(wr * 64 + fr, fq * 8), boff = lds_byte(wc * 32 + fr, fq * 8);
#define PG8_SA(b, h) (((b) * 2 + (h)) * HTB)
#define PG8_SB(b, h) ((4 + (b) * 2 + (h)) * HTB)
#define PG8_STAGE(bufoff, gbase, voff) do { _Pragma("unroll") for (int _i = 0; _i < 2; ++_i) \
        __builtin_amdgcn_global_load_lds((const unsigned*)((const char*)(gbase) + (voff)[_i]), (PG8_LAS unsigned*)(lds + (bufoff) + ldsw + _i * 8192), 16, 0, 0); } while (0)
#define PG8_LDA(dst, b, h) do { _Pragma("unroll") for (int m = 0; m < 4; ++m) _Pragma("unroll") for (int k = 0; k < 2; ++k) dst[m][k] = *(const PG8_LAS bf16x8*)(lds + PG8_SA(b, h) + aoff + m * 2048 + k * 1024); } while (0)
#define PG8_LDB(dst, b, h) do { _Pragma("unroll") for (int n = 0; n < 2; ++n) _Pragma("unroll") for (int k = 0; k < 2; ++k) dst[n][k] = *(const PG8_LAS bf16x8*)(lds + PG8_SB(b, h) + boff + n * 2048 + k * 1024); } while (0)
#define PG8_MMA(ai, bj, At, Bt) do { __builtin_amdgcn_s_setprio(1); _Pragma("unroll") for (int m = 0; m < 4; ++m) _Pragma("unroll") for (int n = 0; n < 2; ++n) _Pragma("unroll") for (int k = 0; k < 2; ++k) \
        acc[ai][bj][m][n] = __builtin_amdgcn_mfma_f32_16x16x32_bf16(Bt[n][k], At[m][k], acc[ai][bj][m][n], 0, 0, 0); __builtin_amdgcn_s_setprio(0); } while (0)
#define PG8_WAIT_V(n) asm volatile("s_waitcnt vmcnt(" #n ")" ::: "memory")
#define PG8_WAIT_L(n) asm volatile("s_waitcnt lgkmcnt(" #n ")" ::: "memory")
#define PG8_BAR __builtin_amdgcn_s_barrier()
#define PG8_SCHED __builtin_amdgcn_sched_barrier(0)
    Unit cur, nxt; int ui = 0;
    if (!S.next(0, cur)) return;
    f32x4 acc[2][2][4][2];
#pragma unroll
    for (int a = 0; a < 2; ++a)
#pragma unroll
        for (int b = 0; b < 2; ++b)
#pragma unroll
            for (int m = 0; m < 4; ++m)
#pragma unroll
                for (int n = 0; n < 2; ++n) acc[a][b][m][n] = (f32x4){0.f, 0.f, 0.f, 0.f};
    bf16x8 At[4][2], B0[2][2], B1[2][2];
    const char* cA = (const char*)g.A + (size_t)cur.pm * tstepA + (g.kmode == 1 ? (size_t)(cur.pn >> 1) * 512 : g.kmode == 2 ? (size_t)(cur.pn % g.ksl) * (size_t)(K * 2) : (size_t)0); const char* cB = (const char*)g.Bt + (g.kmode == 2 ? (size_t)(cur.pn / g.ksl) * tstepB + (size_t)(cur.pn % g.ksl) * (size_t)(K * 2) : (size_t)cur.pn * tstepB);
    S.a_ready(cur);
    if constexpr (SP2) {
        PG8_STAGE(PG8_SB(0, 0), cB, voffB); PG8_STAGE(PG8_SB(0, 1), cB + hstepB, voffB); PG8_STAGE(PG8_SA(0, 0), cA, voffA); PG8_STAGE(PG8_SA(0, 1), cA + hstepA, voffA);
        if (wr == 1) PG8_BAR;
        PG8_WAIT_V(2); PG8_BAR;
        PG8_STAGE(PG8_SB(1, 0), cB + kstep, voffB); PG8_STAGE(PG8_SA(1, 0), cA + kstep, voffA); PG8_STAGE(PG8_SB(1, 1), cB + hstepB + kstep, voffB);
        PG8_WAIT_V(6); PG8_BAR;
    } else {
        PG8_STAGE(PG8_SB(0, 0), cB, voffB); PG8_STAGE(PG8_SA(0, 0), cA, voffA); PG8_STAGE(PG8_SB(0, 1), cB + hstepB, voffB); PG8_STAGE(PG8_SA(0, 1), cA + hstepA, voffA);
        if (wr == 1) PG8_BAR;
        PG8_WAIT_V(4); PG8_BAR;
        PG8_STAGE(PG8_SB(1, 0), cB + kstep, voffB); PG8_STAGE(PG8_SA(1, 0), cA + kstep, voffA); PG8_STAGE(PG8_SB(1, 1), cB + hstepB + kstep, voffB);
        PG8_WAIT_V(6); PG8_BAR;
    }
    for (;;) {
        const bool has_next = S.next(ui + 1, nxt);
        const char* nA = has_next ? (const char*)g.A + (size_t)nxt.pm * tstepA + (g.kmode == 1 ? (size_t)(nxt.pn >> 1) * 512 : g.kmode == 2 ? (size_t)(nxt.pn % g.ksl) * (size_t)(K * 2) : (size_t)0) : cA; const char* nB = has_next ? (const char*)g.Bt + (g.kmode == 2 ? (size_t)(nxt.pn / g.ksl) * tstepB + (size_t)(nxt.pn % g.ksl) * (size_t)(K * 2) : (size_t)nxt.pn * tstepB) : cB;
        for (int t = 0; t < nt; t += 2) {
            const bool last = (t == nt - 2);
            const char* a1 = cA + (size_t)(t + 1) * kstep;
            const char* a2 = last ? nA : cA + (size_t)(t + 2) * kstep; const char* b2 = last ? nB : cB + (size_t)(t + 2) * kstep;
            const char* a3 = a2 + kstep; const char* b3 = b2 + kstep;
            if (last && has_next) S.a_ready(nxt);
            if constexpr (SP2) {
            PG8_LDB(B0, 0, 0); PG8_LDB(B1, 0, 1); PG8_SCHED; PG8_LDA(At, 0, 0); PG8_STAGE(PG8_SA(1, 1), a1 + hstepA, voffA);
            PG8_WAIT_V(8); PG8_WAIT_L(0); PG8_BAR; PG8_MMA(0, 0, At, B0); PG8_MMA(0, 1, At, B1); PG8_BAR; PG8_SCHED;
            PG8_LDA(At, 0, 1); PG8_STAGE(PG8_SB(0, 0), b2, voffB); PG8_STAGE(PG8_SB(0, 1), b2 + hstepB, voffB); PG8_STAGE(PG8_SA(0, 0), a2, voffA);
            PG8_WAIT_V(8); PG8_WAIT_L(0); PG8_BAR; PG8_MMA(1, 0, At, B0); PG8_MMA(1, 1, At, B1); PG8_BAR; PG8_SCHED;
            PG8_LDB(B0, 1, 0); PG8_LDB(B1, 1, 1); PG8_SCHED; PG8_LDA(At, 1, 0); PG8_STAGE(PG8_SA(0, 1), a2 + hstepA, voffA);
            PG8_WAIT_V(8); PG8_WAIT_L(0); PG8_BAR; PG8_MMA(0, 0, At, B0); PG8_MMA(0, 1, At, B1); PG8_BAR; PG8_SCHED;
            PG8_LDA(At, 1, 1); PG8_STAGE(PG8_SB(1, 0), b3, voffB); PG8_STAGE(PG8_SB(1, 1), b3 + hstepB, voffB); PG8_STAGE(PG8_SA(1, 0), a3, voffA);
            PG8_WAIT_V(8); PG8_WAIT_L(0); PG8_BAR; PG8_MMA(1, 0, At, B0); PG8_MMA(1, 1, At, B1); PG8_BAR; PG8_SCHED;
            } else {
            PG8_LDB(B0, 0, 0); PG8_SCHED; PG8_LDA(At, 0, 0); PG8_STAGE(PG8_SA(1, 1), a1 + hstepA, voffA);
            PG8_WAIT_L(8); PG8_BAR; PG8_WAIT_L(0); PG8_MMA(0, 0, At, B0); PG8_BAR; PG8_SCHED;
            PG8_LDB(B1, 0, 1); PG8_STAGE(PG8_SB(0, 0), b2, voffB);
            PG8_BAR; PG8_WAIT_L(0); PG8_MMA(0, 1, At, B1); PG8_BAR;
            PG8_LDA(At, 0, 1); PG8_STAGE(PG8_SA(0, 0), a2, voffA);
            PG8_BAR; PG8_WAIT_L(0); PG8_MMA(1, 0, At, B0); PG8_BAR; PG8_SCHED;
            PG8_STAGE(PG8_SB(0, 1), b2 + hstepB, voffB);
            PG8_WAIT_V(6); PG8_BAR; PG8_MMA(1, 1, At, B1); PG8_BAR;
            PG8_LDB(B0, 1, 0); PG8_SCHED; PG8_LDA(At, 1, 0); PG8_STAGE(PG8_SA(0, 1), a2 + hstepA, voffA);
            PG8_WAIT_L(8); PG8_BAR; PG8_WAIT_L(0); PG8_MMA(0, 0, At, B0); PG8_BAR; PG8_SCHED;
            PG8_LDB(B1, 1, 1); PG8_STAGE(PG8_SB(1, 0), b3, voffB);
            PG8_BAR; PG8_WAIT_L(0); PG8_MMA(0, 1, At, B1); PG8_BAR;
            PG8_LDA(At, 1, 1); PG8_STAGE(PG8_SA(1, 0), a3, voffA);
            PG8_BAR; PG8_WAIT_L(0); PG8_MMA(1, 0, At, B0); PG8_BAR; PG8_SCHED;
            PG8_STAGE(PG8_SB(1, 1), b3 + hstepB, voffB);
            PG8_WAIT_V(6); PG8_BAR; PG8_MMA(1, 1, At, B1); PG8_BAR;
            }
        }
        if constexpr (ALIGN_EPI) { if (wr == 0) PG8_BAR; }
        if constexpr (!Epi::AFTER_DRAIN) { E(acc, cur, wr, wc, fr, fq); S.done(cur); }
        if (!has_next) break;
#pragma unroll
        for (int a = 0; a < 2; ++a)
#pragma unroll
            for (int b = 0; b < 2; ++b)
#pragma unroll
                for (int m = 0; m < 4; ++m)
#pragma unroll
                    for (int n = 0; n < 2; ++n) acc[a][b][m][n] = (f32x4){0.f, 0.f, 0.f, 0.f};
        cur = nxt; cA = nA; cB = nB; ++ui;
        if constexpr (ALIGN_EPI) { if (wr == 1) PG8_BAR; }
    }
    PG8_WAIT_V(0);
    if constexpr (!ALIGN_EPI) { if (wr == 0) PG8_BAR; }
    PG8_BAR;
    if constexpr (Epi::AFTER_DRAIN) { E.fused(acc, cur, wr, wc, fr, fq, lds, wid, lane); S.done(cur); }
#undef PG8_SA
#undef PG8_SB
#undef PG8_STAGE
#undef PG8_LDA
#undef PG8_LDB
#undef PG8_MMA
#undef PG8_WAIT_V
#undef PG8_WAIT_L
#undef PG8_BAR
#undef PG8_SCHED
}
}


constexpr int D = 1024, DFF = 2816, TP = 2064  , NPR = 8 * TP  , NSM = 512, MR = NPR + NSM  , MP = 17152  ;
constexpr float EPS = 1e-6f;
constexpr int MAINR = 16384  , XROWS = MP - MAINR  ;
constexpr size_t O_YP = 0, O_YS = 16777216, O_RCP = 17301504, O_RHP = 17326080, O_SCP = 17334272, O_RCS = 17350656, O_RHS = 17743872, O_SCS = 17874944;
constexpr size_t MiB = 1u << 20;
constexpr size_t WS_WIN0 = 1 * MiB, WS_WG = 5 * MiB, WS_WOUT0 = 6 * MiB, WS_WSCIN = 8 * MiB, WS_WSCOUT = 14 * MiB, WS_WGU = 16 * MiB, WS_WD = 38 * MiB;
constexpr size_t WS_XMETA = 49 * MiB, WS_STATS = 50 * MiB, WS_AGG = 52 * MiB, WS_HN = 56 * MiB, WS_Y = 90 * MiB, WS_R1 = 124 * MiB, WS_R1B = 158 * MiB, WS_Y2 = 218 * MiB, WS_END = 252 * MiB;
static_assert(WS_HN + (size_t)MP * D * 2 <= WS_Y && WS_Y + (size_t)MP * D * 2 <= WS_R1 && WS_R1 + (size_t)MP * D * 2 <= WS_R1B && WS_R1 + (size_t)MP * DFF * 2 <= WS_Y2 && WS_Y2 + (size_t)MP * D * 2 <= WS_END, "ws map");
constexpr int LDS_BYTES = 135168;

#define GAS __attribute__((address_space(1)))
#define LAS __attribute__((address_space(3)))
typedef unsigned short bf16;
typedef unsigned v4u __attribute__((ext_vector_type(4)));
typedef unsigned v2u __attribute__((ext_vector_type(2)));
typedef float f32x4 __attribute__((ext_vector_type(4)));
typedef float f32x16 __attribute__((ext_vector_type(16)));
typedef short bf16x8 __attribute__((ext_vector_type(8)));

struct Args { const float* in[25]; float* out; unsigned char* ws; };

__device__ __forceinline__ unsigned pk2(float lo, float hi) { return pg8::cvt_pk_bf16(lo, hi); }
__device__ __forceinline__ float bflo(unsigned w) { return __uint_as_float(w << 16); }
__device__ __forceinline__ float bfhi(unsigned w) { return __uint_as_float(w & 0xffff0000u); }
__device__ __forceinline__ float sigmoidf_(float x) { return __builtin_amdgcn_rcpf(1.0f + __expf(-x)); }
__device__ __forceinline__ float gelu_tanh(float x) { const float z = 1.5957691216f * (x + 0.044715f * x * x * x); return x * sigmoidf_(z); }
__device__ __forceinline__ float silu_(float x) { return x * sigmoidf_(x); }
__device__ __forceinline__ float wave_sum(float v) {
#pragma unroll
    for (int o = 1; o < 64; o <<= 1) v += __shfl_xor(v, o);
    return v;
}
#define LDS_WAIT() asm volatile("s_waitcnt lgkmcnt(0)" ::: "memory")

__device__ __forceinline__ void st16_wt(bf16* p, v4u w) { asm volatile("global_store_dwordx4 %0, %1, off sc0 sc1\n\ts_nop 1" :: "v"((GAS v4u*)p), "v"(w) : "memory"); }
__device__ __forceinline__ void st16f_wt(GAS f32x4* p, f32x4 w) { asm volatile("global_store_dwordx4 %0, %1, off sc0 sc1\n\ts_nop 1" :: "v"(p), "v"(w) : "memory"); }
__device__ __forceinline__ void st8_wt(GAS v2u* p, v2u w) { asm volatile("global_store_dwordx2 %0, %1, off sc0 sc1\n\ts_nop 1" :: "v"(p), "v"(w) : "memory"); }
__device__ __forceinline__ void st4_wt(float* p, float v) { asm volatile("global_store_dword %0, %1, off sc0 sc1\n\ts_nop 1" :: "v"((GAS float*)p), "v"(v) : "memory"); }
struct EpiGen {
    static constexpr bool PERM = true, AFTER_DRAIN = false;
    int mode;
    bf16* O0; bf16* O1; float* stats;
    const bf16* XC; const float* pa; const float* pb; const float* pl;
    int ksl;
    __device__ __forceinline__ void operator()(const pg8::f32x4 (&acc)[2][2][4][2], const pg8::Unit& u, int wr, int wc, int fr, int fq) const {
        const int row0 = u.pm * 256 + wr * 64 + fr;
        if (mode == 5) {
            const int ks = u.pn % ksl, pnr = u.pn / ksl;
            bf16* base = O1 + ((size_t)ks * XROWS + (size_t)(row0 - MAINR)) * D + pnr * 256 + wc * 32 + 8 * fq;
#pragma unroll
            for (int ai = 0; ai < 2; ++ai)
#pragma unroll
                for (int m = 0; m < 4; ++m) {
                    bf16* rowp = base + (size_t)(ai * 128 + m * 16) * D;
#pragma unroll
                    for (int bj = 0; bj < 2; ++bj) { const pg8::f32x4 v0 = acc[ai][bj][m][0], v1 = acc[ai][bj][m][1];
                        v4u w; w.x = pk2(v0[0], v0[1]); w.y = pk2(v0[2], v0[3]); w.z = pk2(v1[0], v1[1]); w.w = pk2(v1[2], v1[3]);
                        st16_wt(rowp + bj * 128, w); }
                }
        } else if (mode == 4) {
            const int c0 = 256 * (u.pn >> 1) + 128 * (u.pn & 1) + wc * 32 + 8 * fq;
            float bA[8], bX[8], sp8[8];
            { const f32x4 a0 = *(const GAS f32x4*)(pa + c0), a1 = *(const GAS f32x4*)(pa + c0 + 4), b0 = *(const GAS f32x4*)(pb + c0), b1 = *(const GAS f32x4*)(pb + c0 + 4), l0 = *(const GAS f32x4*)(pl + c0), l1 = *(const GAS f32x4*)(pl + c0 + 4);
#pragma unroll
                for (int i = 0; i < 4; ++i) { bA[i] = a0[i]; bA[4 + i] = a1[i]; bX[i] = b0[i]; bX[4 + i] = b1[i]; sp8[i] = -8.0f * log1pf(__expf(-l0[i])); sp8[4 + i] = -8.0f * log1pf(__expf(-l1[i])); } }
#pragma unroll
            for (int ai = 0; ai < 2; ++ai)
#pragma unroll
                for (int m = 0; m < 4; ++m) {
                    const size_t off = (size_t)(row0 + ai * 128 + m * 16) * D + c0;
                    const v4u xq = *(const GAS v4u*)(XC + off);
                    float xc[8] = {bflo(xq.x), bfhi(xq.x), bflo(xq.y), bfhi(xq.y), bflo(xq.z), bfhi(xq.z), bflo(xq.w), bfhi(xq.w)};
                    float om[8], uu[8];
#pragma unroll
                    for (int n = 0; n < 2; ++n)
#pragma unroll
                        for (int i = 0; i < 4; ++i) { const int e = 4 * n + i;
                            const float r = sigmoidf_(acc[ai][0][m][n][i] + bA[e]), ig = sigmoidf_(acc[ai][1][m][n][i] + bX[e]);
                            const float av = __expf(sp8[e] * r), o1 = 1.0f - av;
                            om[e] = o1; uu[e] = __builtin_amdgcn_sqrtf(fmaxf(o1 * (1.0f + av), 0.f)) * ig * xc[e]; }
                    v4u w; w.x = pk2(om[0], om[1]); w.y = pk2(om[2], om[3]); w.z = pk2(om[4], om[5]); w.w = pk2(om[6], om[7]);
                    st16_wt(O0 + off, w);
                    w.x = pk2(uu[0], uu[1]); w.y = pk2(uu[2], uu[3]); w.z = pk2(uu[4], uu[5]); w.w = pk2(uu[6], uu[7]);
                    st16_wt(O1 + off, w);
                }
        } else if (mode == 3) {
            bf16* base = O0 + (size_t)row0 * D + u.pn * 256 + wc * 32 + 8 * fq;
#pragma unroll
            for (int ai = 0; ai < 2; ++ai)
#pragma unroll
                for (int m = 0; m < 4; ++m) {
                    bf16* rowp = base + (size_t)(ai * 128 + m * 16) * D; float ss = 0.f;
#pragma unroll
                    for (int bj = 0; bj < 2; ++bj) { const pg8::f32x4 v0 = acc[ai][bj][m][0], v1 = acc[ai][bj][m][1];
                        ss += (v0[0] * v0[0] + v0[1] * v0[1]) + (v0[2] * v0[2] + v0[3] * v0[3]) + (v1[0] * v1[0] + v1[1] * v1[1]) + (v1[2] * v1[2] + v1[3] * v1[3]);
                        v4u w; w.x = pk2(v0[0], v0[1]); w.y = pk2(v0[2], v0[3]); w.z = pk2(v1[0], v1[1]); w.w = pk2(v1[2], v1[3]);
                        st16_wt(rowp + bj * 128, w); }
                    ss += __shfl_xor(ss, 16); ss += __shfl_xor(ss, 32);
                    if (fq == 0) st4_wt(stats + (size_t)(row0 + ai * 128 + m * 16) * 16 + u.pn * 4 + wc, ss);
                }
        } else if (mode == 1 || (mode == 2 && u.pn >= 4)) {
            const int ldc = (mode == 1) ? DFF : D; const int q = (mode == 1) ? u.pn : (u.pn - 4);
            bf16* base = (mode == 1 ? O0 : O1) + (size_t)row0 * ldc + q * 128 + wc * 32 + 8 * fq;
#pragma unroll
            for (int ai = 0; ai < 2; ++ai)
#pragma unroll
                for (int m = 0; m < 4; ++m) {
                    pg8::f32x4 g0 = acc[ai][0][m][0], g1 = acc[ai][0][m][1]; const pg8::f32x4 u0 = acc[ai][1][m][0], u1 = acc[ai][1][m][1];
                    if (mode == 1) {
#pragma unroll
                        for (int i = 0; i < 4; ++i) { g0[i] = silu_(g0[i]); g1[i] = silu_(g1[i]); } }
                    g0 = g0 * u0; g1 = g1 * u1;
                    v4u w; w.x = pk2(g0[0], g0[1]); w.y = pk2(g0[2], g0[3]); w.z = pk2(g1[0], g1[1]); w.w = pk2(g1[2], g1[3]);
                    st16_wt(base + (size_t)(ai * 128 + m * 16) * ldc, w);
                }
        } else {
            const bool act = (mode == 0 && u.pn < 4);
            bf16* base = (u.pn < 4 ? O0 : O1) + (size_t)row0 * D + (u.pn & 3) * 256 + wc * 32 + 8 * fq;
#pragma unroll
            for (int ai = 0; ai < 2; ++ai)
#pragma unroll
                for (int m = 0; m < 4; ++m) {
                    bf16* rowp = base + (size_t)(ai * 128 + m * 16) * D;
#pragma unroll
                    for (int bj = 0; bj < 2; ++bj) { pg8::f32x4 v0 = acc[ai][bj][m][0], v1 = acc[ai][bj][m][1];
                        if (act) {
#pragma unroll
                            for (int i = 0; i < 4; ++i) { v0[i] = gelu_tanh(v0[i]); v1[i] = gelu_tanh(v1[i]); } }
                        v4u w; w.x = pk2(v0[0], v0[1]); w.y = pk2(v0[2], v0[3]); w.z = pk2(v1[0], v1[1]); w.w = pk2(v1[2], v1[3]);
                        st16_wt(rowp + bj * 128, w); }
                }
        }
    }
};

__device__ __forceinline__ float* xrow(const Args& a, int r) {
    if (r < NPR) { const int b = r / TP, t = r - b * TP;
        if (t < 16) return (float*)(a.ws + WS_XMETA) + (size_t)(b * 16 + t) * D;
        return a.out + O_YP + (size_t)(b * 2048 + (t - 16)) * D; }
    return a.out + O_YS + (size_t)(r - NPR) * D;
}
__device__ __forceinline__ const float* xsrc(const Args& a, int r) {
    if (r < NPR) { const int b = r / TP, t = r - b * TP;
        if (t < 16) return a.in[5] + (size_t)t * D;
        return a.in[0] + (size_t)(b * 2048 + (t - 16)) * D; }
    return a.in[1] + (size_t)(r - NPR) * D;
}

__device__ __forceinline__ int rowmap(int kind, int n) {
    if (kind == 0) return n;
    if (kind == 1) return 256 * (n >> 7) + (n & 127);
    if (kind == 2) return 256 * (n >> 7) + 128 + (n & 127);
    if (n < 1024) return n;
    if (n < 2048) { const int c = n - 1024; return 1024 + 256 * (c >> 7) + (c & 127); }
    { const int c = n - 2048; return 1024 + 256 * (c >> 7) + 128 + (c & 127); }
}
__device__ __forceinline__ void transpose_item(const float* W, int K, int N, bf16* WT, int kind, LAS float* scr, int item, int lane) {
    const int nblk = N / 32, kb = item / nblk, nb = item - kb * nblk, k0 = 64 * kb, n0 = 32 * nb;
    const GAS float* Wg = (const GAS float*)W;
#pragma unroll 8
    for (int i = 0; i < 32; ++i) { const int kk = 2 * i + (lane >> 5); scr[kk * 33 + (lane & 31)] = Wg[(size_t)(k0 + kk) * N + n0 + (lane & 31)]; }
    LDS_WAIT(); asm volatile("" ::: "memory");
    const int c = lane & 7; const int rb = rowmap(kind, n0);
#pragma unroll
    for (int j = 0; j < 4; ++j) { const int n = (lane >> 3) + 8 * j; const LAS float* s = scr + (8 * c) * 33 + n;
        v4u o; o.x = pk2(s[0 * 33], s[1 * 33]); o.y = pk2(s[2 * 33], s[3 * 33]); o.z = pk2(s[4 * 33], s[5 * 33]); o.w = pk2(s[6 * 33], s[7 * 33]);
        *(GAS v4u*)(WT + (size_t)(rb + n) * K + k0 + 8 * c) = o; }
    LDS_WAIT(); asm volatile("" ::: "memory");
}
constexpr int I_IN0 = 16 * 64, I_G = 4 * 8, I_O = 16 * 32, I_SC = 16 * 96, I_GU = 16 * 88, I_DN = 44 * 32;
constexpr int NITEMS = I_IN0 + 8 * I_G + 2 * I_O + I_SC + 4 * I_GU + 2 * I_DN, NITEMS_A = I_IN0 + 8 * I_G;
__device__ __forceinline__ void p0_item(const Args& a, LAS float* scr, int it, int lane) {
    unsigned char* ws = a.ws;
    do {
        int r = it;
        if (r < I_IN0) { transpose_item(a.in[10], 1024, 2048, (bf16*)(ws + WS_WIN0), 0, scr, r, lane); continue; } r -= I_IN0;
        if (r < 8 * I_G) { const int m = r / I_G, h = m & 3, gx = m >> 2;
            transpose_item(a.in[gx ? 15 : 13] + (size_t)h * 65536, 256, 256, (bf16*)(ws + WS_WG) + (size_t)h * 131072, gx ? 2 : 1, scr, r - m * I_G, lane); continue; } r -= 8 * I_G;
        if (r < I_O) { transpose_item(a.in[18], 1024, 1024, (bf16*)(ws + WS_WOUT0), 0, scr, r, lane); continue; } r -= I_O;
        if (r < I_SC) { transpose_item(a.in[19], 1024, 3072, (bf16*)(ws + WS_WSCIN), 3, scr, r, lane); continue; } r -= I_SC;
        if (r < I_O) { transpose_item(a.in[21], 1024, 1024, (bf16*)(ws + WS_WSCOUT), 0, scr, r, lane); continue; } r -= I_O;
        if (r < 4 * I_GU) { const int m = r / I_GU, l = m & 1, up = m >> 1;
            transpose_item(a.in[up ? 23 : 22] + (size_t)l * 1024 * DFF, 1024, DFF, (bf16*)(ws + WS_WGU) + (size_t)l * 5632 * 1024, up ? 2 : 1, scr, r - m * I_GU, lane); continue; } r -= 4 * I_GU;
        { const int l = r / I_DN; transpose_item(a.in[24] + (size_t)l * DFF * 1024, DFF, 1024, (bf16*)(ws + WS_WD) + (size_t)l * 1024 * DFF, 0, scr, r - l * I_DN, lane); }
    } while (0);
}
__device__ __forceinline__ void p0_phase(const Args& a, LAS unsigned char* lds, int wave, int lane) {
    { int t_ = lane_id(); asm volatile("" : "+v"(t_)); lane = t_; }
    LAS float* scr = (LAS float*)(lds + wave * 16384);
    const int gw = blockIdx.x * 8 + wave, NGW = gridDim.x * 8;
    unsigned char* ws = a.ws;
    for (int it = gw; it < NITEMS_A; it += NGW) p0_item(a, scr, it, lane);
    const GAS f32x4* wq = (const GAS f32x4*)a.in[6] + lane;
    f32x4 wpre[4];
#pragma unroll
    for (int j = 0; j < 4; ++j) wpre[j] = wq[64 * j];
    bf16* HN = (bf16*)(ws + WS_HN);
    for (int r0 = gw; r0 < MR; r0 += 2 * NGW) {
        f32x4 v[2][4]; float ss[2] = {0.f, 0.f};
#pragma unroll
        for (int u = 0; u < 2; ++u) { const int r = (r0 + u * NGW < MR) ? r0 + u * NGW : r0; const GAS f32x4* xs = (const GAS f32x4*)xsrc(a, r) + lane;
#pragma unroll
            for (int j = 0; j < 4; ++j) v[u][j] = xs[64 * j]; }
#pragma unroll
        for (int u = 0; u < 2; ++u) {
#pragma unroll
            for (int j = 0; j < 4; ++j) ss[u] += (v[u][j].x * v[u][j].x + v[u][j].y * v[u][j].y) + (v[u][j].z * v[u][j].z + v[u][j].w * v[u][j].w);
            const float rs = rsqrtf(wave_sum(ss[u]) * (1.0f / D) + EPS);
            const int r = r0 + u * NGW;
            if (r < MR) { GAS v2u* o8 = (GAS v2u*)(HN + (size_t)r * D) + lane;
#pragma unroll
                for (int j = 0; j < 4; ++j) { const f32x4 h = v[u][j] * rs * wpre[j]; v2u o; o.x = pk2(h.x, h.y); o.y = pk2(h.z, h.w); o8[64 * j] = o; } }
        }
    }
}

constexpr int CW_CNT = 4096, CW_BANK = 8192, CW_Q = CW_CNT + 14 * CW_BANK, CTL_WORDS = CW_Q + 8 * 64;
__device__ __forceinline__ unsigned ld_rlx(unsigned* p) { return __hip_atomic_load(p, __ATOMIC_RELAXED, __HIP_MEMORY_SCOPE_AGENT); }
struct PubOrder : pg8::StaticOrder {
    unsigned* cnt;
    __device__ __forceinline__ void done(const pg8::Unit& u) const {
        asm volatile("s_waitcnt vmcnt(0)" ::: "memory");
        if (lane_id() == 0) __hip_atomic_fetch_add(cnt + 64 * u.pm, 1u, __ATOMIC_RELAXED, __HIP_MEMORY_SCOPE_AGENT);
    }
};
struct ExtraOrder : PubOrder {
    int ksl;
    __device__ __forceinline__ bool next(int i, pg8::Unit& u) const { const int L = i * G + c; if (L >= 12 * ksl) return false; u.pm = 64 + L / (4 * ksl); u.pn = L % (4 * ksl); return true; }
};
struct CountedOrder : pg8::StaticOrder {
    unsigned* gready; unsigned gneed;
    unsigned* ready; unsigned need, need66; int wv;
    unsigned* gcnt;
    unsigned* cnt;
    __device__ __forceinline__ void a_ready(const pg8::Unit& u) const {
        if (wv == 0) {
            const unsigned nd = (u.pm < 66) ? need : need66;
            unsigned sp = 0;
            while ((unsigned)__builtin_amdgcn_readfirstlane(__hip_atomic_load(ready + 64 * u.pm, __ATOMIC_RELAXED, __HIP_MEMORY_SCOPE_AGENT)) < nd) { __builtin_amdgcn_s_sleep(2); if (++sp > (1u << 18)) break; }
            if (gready) { while ((unsigned)__builtin_amdgcn_readfirstlane(__hip_atomic_load(gready, __ATOMIC_RELAXED, __HIP_MEMORY_SCOPE_AGENT)) < gneed) { __builtin_amdgcn_s_sleep(2); if (++sp > (1u << 18)) break; } }
            __builtin_amdgcn_fence(__ATOMIC_ACQUIRE, "agent");
            asm volatile("s_waitcnt vmcnt(0)" ::: "memory");
        }
        asm volatile("" ::: "memory"); __builtin_amdgcn_s_barrier(); asm volatile("" ::: "memory");
    }
    __device__ __forceinline__ void done(const pg8::Unit& u) const {
        if (cnt) { asm volatile("s_waitcnt vmcnt(0)" ::: "memory");
            if (lane_id() == 0) { __hip_atomic_fetch_add(cnt + 64 * u.pm, 1u, __ATOMIC_RELAXED, __HIP_MEMORY_SCOPE_AGENT); if (gcnt) __hip_atomic_fetch_add(gcnt, 1u, __ATOMIC_RELAXED, __HIP_MEMORY_SCOPE_AGENT); } }
    }
};
struct ExtraOrderC : CountedOrder {
    int ksl;
    __device__ __forceinline__ bool next(int i, pg8::Unit& u) const { const int L = i * G + c; if (L >= 12 * ksl) return false; u.pm = 64 + L / (4 * ksl); u.pn = L % (4 * ksl); return true; }
};
#define TAIL_BEGIN(BANK, NCHUNKS, NEED, PLO_EXPR, PHI_EXPR) \
    for (;;) { __syncthreads(); \
        if (wave == 0 && lane_id() == 0) { const unsigned c_ = __hip_atomic_fetch_add(ctl + CW_Q + 64 * (BANK), 1u, __ATOMIC_RELAXED, __HIP_MEMORY_SCOPE_AGENT); \
            if (c_ < (unsigned)(NCHUNKS)) { const int chunk = (int)c_; const int plo_ = (PLO_EXPR), phi_ = (PHI_EXPR); \
                for (int p_ = plo_; p_ <= phi_; ++p_) { unsigned sp_ = 0; while (ld_rlx(ctl + CW_CNT + (BANK) * CW_BANK + 64 * p_) < (unsigned)(NEED)) { __builtin_amdgcn_s_sleep(2); if (++sp_ > (1u << 18)) break; } } \
                __builtin_amdgcn_fence(__ATOMIC_ACQUIRE, "agent"); asm volatile("s_waitcnt vmcnt(0)" ::: "memory"); } \
            *bc = c_; } \
        __syncthreads(); \
        const unsigned cu_ = *bc; if (cu_ >= (unsigned)(NCHUNKS)) break; const int chunk = (int)cu_;
#define TAIL_END }
#define TAIL_BEGIN_PUB(BANK, PUBBANK, NCHUNKS, NEED, PLO_EXPR, PHI_EXPR) \
    int prevp_ = -1; \
    for (;;) { __syncthreads(); \
        if (wave == 0 && lane_id() == 0) { \
            if (prevp_ >= 0) { __hip_atomic_fetch_add(ctl + CW_CNT + (PUBBANK) * CW_BANK + 64 * prevp_, 1u, __ATOMIC_RELAXED, __HIP_MEMORY_SCOPE_AGENT); \
                               __hip_atomic_fetch_add(ctl + CW_CNT + (PUBBANK) * CW_BANK + 64 * 100, 1u, __ATOMIC_RELAXED, __HIP_MEMORY_SCOPE_AGENT); } \
            const unsigned c_ = __hip_atomic_fetch_add(ctl + CW_Q + 64 * (BANK), 1u, __ATOMIC_RELAXED, __HIP_MEMORY_SCOPE_AGENT); \
            if (c_ < (unsigned)(NCHUNKS)) { const int chunk = (int)c_; const int plo_ = (PLO_EXPR), phi_ = (PHI_EXPR); \
                for (int p_ = plo_; p_ <= phi_; ++p_) { unsigned sp_ = 0; while (ld_rlx(ctl + CW_CNT + (BANK) * CW_BANK + 64 * p_) < (unsigned)(NEED)) { __builtin_amdgcn_s_sleep(2); if (++sp_ > (1u << 18)) break; } } \
                __builtin_amdgcn_fence(__ATOMIC_ACQUIRE, "agent"); asm volatile("s_waitcnt vmcnt(0)" ::: "memory"); } \
            *bc = c_; } \
        __syncthreads(); \
        const unsigned cu_ = *bc; if (cu_ >= (unsigned)(NCHUNKS)) break; const int chunk = (int)cu_; prevp_ = (PHI_EXPR);

__device__ __forceinline__ void p0b_tail(const Args& a, LAS unsigned char* lds, int wave, int lane, unsigned* ctl, volatile LAS unsigned* bc) {
    { int t_ = lane_id(); asm volatile("" : "+v"(t_)); lane = t_; }
    LAS float* scr = (LAS float*)(lds + wave * 16384);
    constexpr int NCH = (NITEMS - NITEMS_A + 7) / 8;
    for (;;) { __syncthreads();
        if (wave == 0 && lane_id() == 0) *bc = __hip_atomic_fetch_add(ctl + CW_Q + 64 * 7, 1u, __ATOMIC_RELAXED, __HIP_MEMORY_SCOPE_AGENT);
        __syncthreads();
        const unsigned c = *bc; if (c >= (unsigned)NCH) break;
        const int it = NITEMS_A + 8 * (int)c + wave;
        if (it < NITEMS) p0_item(a, scr, it, lane);
    }
}
template <bool FIRST, int XS, int PUB>
__device__ __forceinline__ void norm_res_tail(const Args& a, const float* wpost_, const float* wpre_, int wave, int lane, unsigned* ctl, int bank, volatile LAS unsigned* bc) {
    { int t_ = lane_id(); asm volatile("" : "+v"(t_)); lane = t_; }
    const GAS f32x4* wp4 = (const GAS f32x4*)wpost_ + lane;
    f32x4 wpost[4], wpre[4];
#pragma unroll
    for (int j = 0; j < 4; ++j) { wpost[j] = wp4[64 * j]; wpre[j] = wpre_ ? ((const GAS f32x4*)wpre_ + lane)[64 * j] : (f32x4){0.f, 0.f, 0.f, 0.f}; }
    const GAS float* stats = (const GAS float*)(a.ws + WS_STATS);
    const bf16* Y = (const bf16*)(a.ws + WS_Y); const bf16* PX = (const bf16*)(a.ws + WS_Y2); bf16* HN = (bf16*)(a.ws + WS_HN);
    int prev_panel = -1;
    for (;;) { __syncthreads();
        if (wave == 0 && lane_id() == 0) {
            if (PUB >= 0 && prev_panel >= 0) __hip_atomic_fetch_add(ctl + CW_CNT + (PUB >= 0 ? PUB : 0) * CW_BANK + 64 * prev_panel, 1u, __ATOMIC_RELAXED, __HIP_MEMORY_SCOPE_AGENT);
            const unsigned c_ = __hip_atomic_fetch_add(ctl + CW_Q + 64 * bank, 1u, __ATOMIC_RELAXED, __HIP_MEMORY_SCOPE_AGENT);
            if (c_ < (unsigned)(MR / 32)) { const int p_ = (int)c_ >> 3; unsigned sp_ = 0;
                while (ld_rlx(ctl + CW_CNT + bank * CW_BANK + 64 * p_) < (unsigned)(p_ < 64 ? 32 : 32 * XS)) { __builtin_amdgcn_s_sleep(2); if (++sp_ > (1u << 18)) break; }
                __builtin_amdgcn_fence(__ATOMIC_ACQUIRE, "agent"); asm volatile("s_waitcnt vmcnt(0)" ::: "memory"); }
            *bc = c_; }
        __syncthreads();
        const unsigned cu_ = *bc; if (cu_ >= (unsigned)(MR / 32)) break; const int chunk = (int)cu_; prev_panel = chunk >> 3;
    if (chunk * 32 < MAINR) {
#pragma unroll
    for (int k = 0; k < 4; ++k) {
        const int r = chunk * 32 + wave * 4 + k;
        GAS f32x4* xp = (GAS f32x4*)xrow(a, r) + lane; const GAS f32x4* xs = (const GAS f32x4*)xsrc(a, r) + lane;
        GAS v2u* xb = (GAS v2u*)((GAS bf16*)xrow(a, r) + D) + lane;
        const GAS v2u* yp = (const GAS v2u*)(Y + (size_t)r * D) + lane;
        float s = (!false && lane < 16) ? stats[(size_t)r * 16 + lane] : 0.f;
        f32x4 v[4], yf[4]; v2u yy[4], y2[4];
#pragma unroll
        for (int j = 0; j < 4; ++j) { if (FIRST) v[j] = xs[64 * j]; else { const v2u q = xb[64 * j]; v[j] = (f32x4){bflo(q.x), bfhi(q.x), bflo(q.y), bfhi(q.y)}; } yy[j] = false ? (v2u){0u, 0u} : yp[64 * j]; }
#pragma unroll
        for (int j = 0; j < 4; ++j) { f32x4 y; y.x = bflo(yy[j].x); y.y = bfhi(yy[j].x); y.z = bflo(yy[j].y); y.w = bfhi(yy[j].y); yf[j] = y; }
        if (false) {
            v2u pq[XS][4];
#pragma unroll
            for (int sl = 0; sl < XS; ++sl) { const GAS v2u* pp = (const GAS v2u*)(PX + ((size_t)sl * XROWS + (size_t)(r - MAINR)) * D) + lane;
#pragma unroll
                for (int j = 0; j < 4; ++j) pq[sl][j] = pp[64 * j]; }
#pragma unroll
            for (int sl = 0; sl < XS; ++sl)
#pragma unroll
                for (int j = 0; j < 4; ++j) { yf[j].x += bflo(pq[sl][j].x); yf[j].y += bfhi(pq[sl][j].x); yf[j].z += bflo(pq[sl][j].y); yf[j].w += bfhi(pq[sl][j].y); }
#pragma unroll
            for (int j = 0; j < 4; ++j) s += (yf[j].x * yf[j].x + yf[j].y * yf[j].y) + (yf[j].z * yf[j].z + yf[j].w * yf[j].w);
        }
        const float rs = rsqrtf(wave_sum(s) * (1.0f / D) + EPS);
        float ss = 0.f;
#pragma unroll
        for (int j = 0; j < 4; ++j) { const f32x4 y = yf[j];
            v[j] = v[j] + y * rs * wpost[j]; if (wpre_) { v2u q; q.x = pk2(v[j].x, v[j].y); q.y = pk2(v[j].z, v[j].w); if (PUB >= 0) st8_wt(xb + 64 * j, q); else xb[64 * j] = q; } else xp[64 * j] = v[j];
            ss += (v[j].x * v[j].x + v[j].y * v[j].y) + (v[j].z * v[j].z + v[j].w * v[j].w); }
        if (wpre_) {
            const float rs1 = rsqrtf(wave_sum(ss) * (1.0f / D) + EPS);
            GAS v2u* o8 = (GAS v2u*)(HN + (size_t)r * D) + lane;
#pragma unroll
            for (int j = 0; j < 4; ++j) { const f32x4 h = v[j] * rs1 * wpre[j]; v2u o; o.x = pk2(h.x, h.y); o.y = pk2(h.z, h.w); if (PUB >= 0) st8_wt(o8 + 64 * j, o); else o8[64 * j] = o; }
        }
    }
    } else {
#pragma unroll 2
    for (int k = 0; k < 4; ++k) {
        const int r = chunk * 32 + wave * 4 + k;
        GAS f32x4* xp = (GAS f32x4*)xrow(a, r) + lane; const GAS f32x4* xs = (const GAS f32x4*)xsrc(a, r) + lane;
        GAS v2u* xb = (GAS v2u*)((GAS bf16*)xrow(a, r) + D) + lane;
        const GAS v2u* yp = (const GAS v2u*)(Y + (size_t)r * D) + lane;
        float s = (!true && lane < 16) ? stats[(size_t)r * 16 + lane] : 0.f;
        f32x4 v[4], yf[4]; v2u yy[4], y2[4];
#pragma unroll
        for (int j = 0; j < 4; ++j) { if (FIRST) v[j] = xs[64 * j]; else { const v2u q = xb[64 * j]; v[j] = (f32x4){bflo(q.x), bfhi(q.x), bflo(q.y), bfhi(q.y)}; } yy[j] = true ? (v2u){0u, 0u} : yp[64 * j]; }
#pragma unroll
        for (int j = 0; j < 4; ++j) { f32x4 y; y.x = bflo(yy[j].x); y.y = bfhi(yy[j].x); y.z = bflo(yy[j].y); y.w = bfhi(yy[j].y); yf[j] = y; }
        if (true) {
            v2u pq[XS][4];
#pragma unroll
            for (int sl = 0; sl < XS; ++sl) { const GAS v2u* pp = (const GAS v2u*)(PX + ((size_t)sl * XROWS + (size_t)(r - MAINR)) * D) + lane;
#pragma unroll
                for (int j = 0; j < 4; ++j) pq[sl][j] = pp[64 * j]; }
#pragma unroll
            for (int sl = 0; sl < XS; ++sl)
#pragma unroll
                for (int j = 0; j < 4; ++j) { yf[j].x += bflo(pq[sl][j].x); yf[j].y += bfhi(pq[sl][j].x); yf[j].z += bflo(pq[sl][j].y); yf[j].w += bfhi(pq[sl][j].y); }
#pragma unroll
            for (int j = 0; j < 4; ++j) s += (yf[j].x * yf[j].x + yf[j].y * yf[j].y) + (yf[j].z * yf[j].z + yf[j].w * yf[j].w);
        }
        const float rs = rsqrtf(wave_sum(s) * (1.0f / D) + EPS);
        float ss = 0.f;
#pragma unroll
        for (int j = 0; j < 4; ++j) { const f32x4 y = yf[j];
            v[j] = v[j] + y * rs * wpost[j]; if (wpre_) { v2u q; q.x = pk2(v[j].x, v[j].y); q.y = pk2(v[j].z, v[j].w); if (PUB >= 0) st8_wt(xb + 64 * j, q); else xb[64 * j] = q; } else xp[64 * j] = v[j];
            ss += (v[j].x * v[j].x + v[j].y * v[j].y) + (v[j].z * v[j].z + v[j].w * v[j].w); }
        if (wpre_) {
            const float rs1 = rsqrtf(wave_sum(ss) * (1.0f / D) + EPS);
            GAS v2u* o8 = (GAS v2u*)(HN + (size_t)r * D) + lane;
#pragma unroll
            for (int j = 0; j < 4; ++j) { const f32x4 h = v[j] * rs1 * wpre[j]; v2u o; o.x = pk2(h.x, h.y); o.y = pk2(h.z, h.w); if (PUB >= 0) st8_wt(o8 + 64 * j, o); else o8[64 * j] = o; }
        }
    }
    }
    if (PUB >= 0) asm volatile("s_waitcnt vmcnt(0)" ::: "memory");
    TAIL_END
}

__device__ __forceinline__ void rgconv_tail(const Args& a, unsigned* ctl, volatile LAS unsigned* bc, const int wave) {
    int tidx = wave * 64 + lane_id(); asm volatile("" : "+v"(tidx));
    const bf16* XR = (const bf16*)(a.ws + WS_R1B); bf16* XC = (bf16*)(a.ws + WS_HN);
    const GAS float* cw = (const GAS float*)a.in[11]; const GAS float* cb = (const GAS float*)a.in[12]; const GAS float* st = (const GAS float*)a.in[2];
    const int ch0 = 8 * (tidx & 127);
    float w[4][8], bb[8];
#pragma unroll
    for (int k = 0; k < 4; ++k) { const f32x4 w0 = *(const GAS f32x4*)(cw + k * D + ch0), w1 = *(const GAS f32x4*)(cw + k * D + ch0 + 4);
        w[k][0] = w0.x; w[k][1] = w0.y; w[k][2] = w0.z; w[k][3] = w0.w; w[k][4] = w1.x; w[k][5] = w1.y; w[k][6] = w1.z; w[k][7] = w1.w; }
    { const f32x4 b0 = *(const GAS f32x4*)(cb + ch0), b1 = *(const GAS f32x4*)(cb + ch0 + 4);
        bb[0] = b0.x; bb[1] = b0.y; bb[2] = b0.z; bb[3] = b0.w; bb[4] = b1.x; bb[5] = b1.y; bb[6] = b1.z; bb[7] = b1.w; }
    TAIL_BEGIN(0, MR / 32, 64, (chunk > 0 ? (32 * chunk - 3) >> 8 : 0), (32 * chunk) >> 8)
    if (32 * chunk < NPR) {
        const int R0 = 32 * chunk + 8 * (tidx >> 7), bq = R0 / TP, t0 = R0 - bq * TP;
        v4u win[11];
#pragma unroll
        for (int wi = 0; wi < 11; ++wi) win[wi] = (t0 - 3 + wi >= 0) ? *(const GAS v4u*)(XR + (size_t)(R0 - 3 + wi) * D + ch0) : (v4u){0u, 0u, 0u, 0u};
#pragma unroll
        for (int i = 0; i < 8; ++i) {
            float c8[8];
#pragma unroll
            for (int e = 0; e < 8; ++e) c8[e] = bb[e];
#pragma unroll
            for (int k = 0; k < 4; ++k) { const v4u q = win[i + k]; const float x[8] = {bflo(q.x), bfhi(q.x), bflo(q.y), bfhi(q.y), bflo(q.z), bfhi(q.z), bflo(q.w), bfhi(q.w)};
#pragma unroll
                for (int e = 0; e < 8; ++e) c8[e] = fmaf(w[k][e], x[e], c8[e]); }
            if (t0 + i >= TP - 3) { const v4u q = win[i + 3]; const float x[8] = {bflo(q.x), bfhi(q.x), bflo(q.y), bfhi(q.y), bflo(q.z), bfhi(q.z), bflo(q.w), bfhi(q.w)};
                GAS float* dst = (GAS float*)a.out + O_RCP + (size_t)(bq * 3 + (t0 + i - (TP - 3))) * D + ch0;
                *(GAS f32x4*)dst = (f32x4){x[0], x[1], x[2], x[3]}; *(GAS f32x4*)(dst + 4) = (f32x4){x[4], x[5], x[6], x[7]}; }
            v4u o; o.x = pk2(c8[0], c8[1]); o.y = pk2(c8[2], c8[3]); o.z = pk2(c8[4], c8[5]); o.w = pk2(c8[6], c8[7]);
            *(GAS v4u*)(XC + (size_t)(R0 + i) * D + ch0) = o;
        }
    } else
#pragma unroll 4
    for (int i_ = 0; i_ < 8; ++i_) {
        const int R = 32 * chunk + (tidx >> 7) + 4 * i_;
        int t, T, bq; const bool is_sample = (R >= NPR);
        if (!is_sample) { bq = R / TP; t = R - bq * TP; T = TP; } else { bq = (R - NPR) >> 2; t = (R - NPR) & 3; T = 4; }
        float c8[8];
#pragma unroll
        for (int e = 0; e < 8; ++e) c8[e] = bb[e];
#pragma unroll
        for (int k = 0; k < 4; ++k) {
            const int tt = t - 3 + k; float x[8];
            if (tt >= 0) { const v4u q = *(const GAS v4u*)(XR + (size_t)(R - 3 + k) * D + ch0);
                x[0] = bflo(q.x); x[1] = bfhi(q.x); x[2] = bflo(q.y); x[3] = bfhi(q.y); x[4] = bflo(q.z); x[5] = bfhi(q.z); x[6] = bflo(q.w); x[7] = bfhi(q.w); }
            else if (is_sample) { const GAS float* sp = st + (size_t)(bq * 3 + (3 + tt)) * D + ch0; const f32x4 q0 = *(const GAS f32x4*)sp, q1 = *(const GAS f32x4*)(sp + 4);
                x[0] = q0.x; x[1] = q0.y; x[2] = q0.z; x[3] = q0.w; x[4] = q1.x; x[5] = q1.y; x[6] = q1.z; x[7] = q1.w; }
            else {
#pragma unroll
                for (int e = 0; e < 8; ++e) x[e] = 0.f; }
#pragma unroll
            for (int e = 0; e < 8; ++e) c8[e] = fmaf(w[k][e], x[e], c8[e]);
            if (k == 3 && t >= T - 3) {
                GAS float* dst = (GAS float*)a.out + (is_sample ? O_RCS : O_RCP) + (size_t)(bq * 3 + (t - (T - 3))) * D + ch0;
                *(GAS f32x4*)dst = (f32x4){x[0], x[1], x[2], x[3]}; *(GAS f32x4*)(dst + 4) = (f32x4){x[4], x[5], x[6], x[7]};
            }
        }
        v4u o; o.x = pk2(c8[0], c8[1]); o.y = pk2(c8[2], c8[3]); o.z = pk2(c8[4], c8[5]); o.w = pk2(c8[6], c8[7]);
        *(GAS v4u*)(XC + (size_t)R * D + ch0) = o;
    }
    TAIL_END
}

__device__ __forceinline__ bool seq_start(int R) { return R < NPR ? (R % TP == 0) : (((R - NPR) & 3) == 0); }
__device__ __forceinline__ bool seq_end(int R) { return R < NPR ? (R % TP == TP - 1) : (((R - NPR) & 3) == 3); }
template <int PASS>
__device__ __forceinline__ void lru_scan_item(const Args& a, LAS unsigned char* lds, const int j, const int q, const int wave, unsigned* ctl = nullptr) {
    int tid_ = wave * 64 + lane_id(); asm volatile("" : "+v"(tid_));
    const int tid = tid_, sub = tid >> 5, oct = tid & 31;
    const bf16* OMA = (const bf16*)(a.ws + WS_Y); const bf16* U = (const bf16*)(a.ws + WS_R1B); const bf16* GG = (const bf16*)(a.ws + WS_R1); bf16* A2 = (bf16*)(a.ws + WS_HN);
    GAS float* AGG = (GAS float*)(a.ws + WS_AGG); const GAS float* sth = (const GAS float*)a.in[3];
    LAS float* sagg = (LAS float*)lds;
    {
        const int ch0 = 256 * q + 8 * oct, Rb = 64 * j + 4 * sub;
        v4u qa[4], qu[4], gq[4];
#pragma unroll
        for (int rr = 0; rr < 4; ++rr) { qa[rr] = *(const GAS v4u*)(OMA + (size_t)(Rb + rr) * D + ch0); qu[rr] = *(const GAS v4u*)(U + (size_t)(Rb + rr) * D + ch0);
            if (PASS == 2) gq[rr] = *(const GAS v4u*)(GG + (size_t)(Rb + rr) * D + ch0); }
        float av[4][8], uv[4][8], h0[4][8];
#pragma unroll
        for (int rr = 0; rr < 4; ++rr) {
            av[rr][0] = 1.f - bflo(qa[rr].x); av[rr][1] = 1.f - bfhi(qa[rr].x); av[rr][2] = 1.f - bflo(qa[rr].y); av[rr][3] = 1.f - bfhi(qa[rr].y);
            av[rr][4] = 1.f - bflo(qa[rr].z); av[rr][5] = 1.f - bfhi(qa[rr].z); av[rr][6] = 1.f - bflo(qa[rr].w); av[rr][7] = 1.f - bfhi(qa[rr].w);
            uv[rr][0] = bflo(qu[rr].x); uv[rr][1] = bfhi(qu[rr].x); uv[rr][2] = bflo(qu[rr].y); uv[rr][3] = bfhi(qu[rr].y);
            uv[rr][4] = bflo(qu[rr].z); uv[rr][5] = bfhi(qu[rr].z); uv[rr][6] = bflo(qu[rr].w); uv[rr][7] = bfhi(qu[rr].w);
            const int R = Rb + rr;
            if (R >= NPR && ((R - NPR) & 3) == 0) { const GAS float* hp = sth + (size_t)((R - NPR) >> 2) * D + ch0; const f32x4 p0 = *(const GAS f32x4*)hp, p1 = *(const GAS f32x4*)(hp + 4);
                h0[rr][0] = p0.x; h0[rr][1] = p0.y; h0[rr][2] = p0.z; h0[rr][3] = p0.w; h0[rr][4] = p1.x; h0[rr][5] = p1.y; h0[rr][6] = p1.z; h0[rr][7] = p1.w; }
            else {
#pragma unroll
                for (int e = 0; e < 8; ++e) h0[rr][e] = 0.f; }
        }
        const bool lookback = (PASS == 2) && (64 * j < NPR);
        if (lookback) {
            const int jt0 = (((64 * j) / TP) * TP) >> 6, n = j - jt0;
            float SA[8], SH[8];
#pragma unroll
            for (int e = 0; e < 8; ++e) { SA[e] = 1.f; SH[e] = 0.f; }
            f32x4 ev[3][4];
#pragma unroll
            for (int k = 0; k < 3; ++k) { const int idx = 3 * sub + k;
                if (idx < n) { const GAS f32x4* src = (const GAS f32x4*)(AGG + ((size_t)(jt0 + idx) * D + ch0) * 2);
#pragma unroll
                    for (int e = 0; e < 4; ++e) ev[k][e] = src[e]; }
                else {
#pragma unroll
                    for (int e = 0; e < 4; ++e) ev[k][e] = (f32x4){1.f, 0.f, 1.f, 0.f}; } }
#pragma unroll
            for (int k = 0; k < 3; ++k) if (3 * sub + k < n) {
#pragma unroll
                for (int e = 0; e < 4; ++e) { const f32x4 v = ev[k][e]; SH[2 * e] = fmaf(v.x, SH[2 * e], v.y); SA[2 * e] *= v.x; SH[2 * e + 1] = fmaf(v.z, SH[2 * e + 1], v.w); SA[2 * e + 1] *= v.z; } }
            LAS f32x4* dst = (LAS f32x4*)(sagg + 8192 + (size_t)(sub * 256 + 8 * oct) * 2);
#pragma unroll
            for (int e = 0; e < 4; ++e) dst[e] = (f32x4){SA[2 * e], SH[2 * e], SA[2 * e + 1], SH[2 * e + 1]};
        }
        float A8[8], H8[8];
#pragma unroll
        for (int e = 0; e < 8; ++e) { A8[e] = 1.f; H8[e] = 0.f; }
#pragma unroll
        for (int rr = 0; rr < 4; ++rr) { const bool st = seq_start(Rb + rr);
#pragma unroll
            for (int e = 0; e < 8; ++e) { const float hp = st ? h0[rr][e] : H8[e]; H8[e] = fmaf(av[rr][e], hp, uv[rr][e]); A8[e] = st ? 0.f : A8[e] * av[rr][e]; } }
        { LAS f32x4* dst = (LAS f32x4*)(sagg + (size_t)(sub * 256 + 8 * oct) * 2);
#pragma unroll
            for (int e = 0; e < 4; ++e) dst[e] = (f32x4){A8[2 * e], H8[2 * e], A8[2 * e + 1], H8[2 * e + 1]}; }
        __syncthreads();
        if (PASS == 1) {
            if (tid < 32) {
                float A[8], H[8];
#pragma unroll
                for (int e = 0; e < 8; ++e) { A[e] = 1.f; H[e] = 0.f; }
#pragma unroll 4
                for (int s = 0; s < 16; ++s) { const LAS f32x4* src = (const LAS f32x4*)(sagg + (size_t)(s * 256 + 8 * oct) * 2);
#pragma unroll
                    for (int e = 0; e < 4; ++e) { const f32x4 v = src[e]; H[2 * e] = fmaf(v.x, H[2 * e], v.y); A[2 * e] *= v.x; H[2 * e + 1] = fmaf(v.z, H[2 * e + 1], v.w); A[2 * e + 1] *= v.z; } }
                GAS f32x4* dst = (GAS f32x4*)(AGG + ((size_t)j * D + ch0) * 2);
#pragma unroll
                for (int e = 0; e < 4; ++e) st16f_wt(dst + e, (f32x4){A[2 * e], H[2 * e], A[2 * e + 1], H[2 * e + 1]});
                asm volatile("s_waitcnt vmcnt(0)" ::: "memory");
            }
        } else {
            float C8[8];
#pragma unroll
            for (int e = 0; e < 8; ++e) C8[e] = 0.f;
            if (lookback) {
                LAS float* tcar = sagg + 16384;
                if (tid < 32) {
#pragma unroll 4
                    for (int sg = 0; sg < 16; ++sg) { const LAS f32x4* src = (const LAS f32x4*)(sagg + 8192 + (size_t)(sg * 256 + 8 * oct) * 2);
#pragma unroll
                        for (int e = 0; e < 4; ++e) { const f32x4 v = src[e]; C8[2 * e] = fmaf(v.x, C8[2 * e], v.y); C8[2 * e + 1] = fmaf(v.z, C8[2 * e + 1], v.w); } }
                    *(LAS f32x4*)(tcar + 8 * oct) = (f32x4){C8[0], C8[1], C8[2], C8[3]}; *(LAS f32x4*)(tcar + 8 * oct + 4) = (f32x4){C8[4], C8[5], C8[6], C8[7]};
                }
                __syncthreads();
                const f32x4 c0 = *(const LAS f32x4*)(tcar + 8 * oct), c1 = *(const LAS f32x4*)(tcar + 8 * oct + 4);
                C8[0] = c0.x; C8[1] = c0.y; C8[2] = c0.z; C8[3] = c0.w; C8[4] = c1.x; C8[5] = c1.y; C8[6] = c1.z; C8[7] = c1.w;
            }
            for (int s = 0; s < sub; ++s) { const LAS f32x4* src = (const LAS f32x4*)(sagg + (size_t)(s * 256 + 8 * oct) * 2);
#pragma unroll
                for (int e = 0; e < 4; ++e) { const f32x4 v = src[e]; C8[2 * e] = fmaf(v.x, C8[2 * e], v.y); C8[2 * e + 1] = fmaf(v.z, C8[2 * e + 1], v.w); } }
#pragma unroll
            for (int rr = 0; rr < 4; ++rr) { const int R = Rb + rr; const bool st = seq_start(R);
                const v4u g = gq[rr];
#pragma unroll
                for (int e = 0; e < 8; ++e) { const float hp = st ? h0[rr][e] : C8[e]; C8[e] = fmaf(av[rr][e], hp, uv[rr][e]); }
                v4u o; o.x = pk2(C8[0] * bflo(g.x), C8[1] * bfhi(g.x)); o.y = pk2(C8[2] * bflo(g.y), C8[3] * bfhi(g.y));
                o.z = pk2(C8[4] * bflo(g.z), C8[5] * bfhi(g.z)); o.w = pk2(C8[6] * bflo(g.w), C8[7] * bfhi(g.w));
                st16_wt(A2 + (size_t)R * D + ch0, o);
                if (seq_end(R)) { GAS float* dst = (GAS float*)a.out + (R < NPR ? O_RHP + (size_t)(R / TP) * D : O_RHS + (size_t)((R - NPR) >> 2) * D) + ch0;
                    *(GAS f32x4*)dst = (f32x4){C8[0], C8[1], C8[2], C8[3]}; *(GAS f32x4*)(dst + 4) = (f32x4){C8[4], C8[5], C8[6], C8[7]}; }
            }
            asm volatile("s_waitcnt vmcnt(0)" ::: "memory");
        }
        __syncthreads();
        if (PASS == 2 && wave == 0 && lane_id() == 0) {
            __hip_atomic_fetch_add(ctl + CW_CNT + 12 * CW_BANK + 64 * (j >> 2), 1u, __ATOMIC_RELAXED, __HIP_MEMORY_SCOPE_AGENT);
            __hip_atomic_fetch_add(ctl + CW_CNT + 12 * CW_BANK + 64 * 100, 1u, __ATOMIC_RELAXED, __HIP_MEMORY_SCOPE_AGENT); }
    }
}

__device__ __forceinline__ void lru_scan1_tail(const Args& a, LAS unsigned char* lds, unsigned* ctl, volatile LAS unsigned* bc, const int wave) {
    TAIL_BEGIN(1, 266 * 2, 64, chunk >> 3, chunk >> 3)
    lru_scan_item<1>(a, lds, chunk >> 1, 2 * (chunk & 1), wave); lru_scan_item<1>(a, lds, chunk >> 1, 2 * (chunk & 1) + 1, wave);
    if (wave == 0 && lane_id() == 0) __hip_atomic_fetch_add(ctl + CW_CNT + 13 * CW_BANK + 16 * (chunk >> 1), 1u, __ATOMIC_RELAXED, __HIP_MEMORY_SCOPE_AGENT);
    TAIL_END
}
__device__ __forceinline__ void lru_scan2_phase(const Args& a, LAS unsigned char* lds, const int wave, unsigned* ctl) {
#pragma unroll 1
    for (int it = blockIdx.x; it < 266 * 4; it += gridDim.x) {
        const int j = it >> 2;
        if (wave == 0) {
            const int jt0 = (64 * j < NPR) ? ((((64 * j) / TP) * TP) >> 6) : j, n = j - jt0, l = lane_id();
            unsigned* w = (l < n) ? ctl + CW_CNT + 13 * CW_BANK + 16 * (jt0 + l) : ctl + CW_CNT + 1 * CW_BANK + 64 * (j >> 2);
            const unsigned nd = (l < n) ? 2u : (l == n ? 64u : 0u);
            unsigned sp = 0;
            while (!__all(__hip_atomic_load(w, __ATOMIC_RELAXED, __HIP_MEMORY_SCOPE_AGENT) >= nd)) { __builtin_amdgcn_s_sleep(2); if (++sp > (1u << 18)) break; }
            __builtin_amdgcn_fence(__ATOMIC_ACQUIRE, "agent"); asm volatile("s_waitcnt vmcnt(0)" ::: "memory");
        }
        __syncthreads();
        lru_scan_item<2>(a, lds, j, it & 3, wave, ctl);
    }
}

__device__ __forceinline__ void sconv_tail(const Args& a, unsigned* ctl, volatile LAS unsigned* bc, const int wave) {
    int tidx = wave * 64 + lane_id(); asm volatile("" : "+v"(tidx));
    const bf16* BG = (const bf16*)(a.ws + WS_R1); const bf16* CV = (const bf16*)(a.ws + WS_R1B); bf16* A3 = (bf16*)(a.ws + WS_HN);
    const GAS float* cw = (const GAS float*)a.in[20]; const GAS float* st = (const GAS float*)a.in[4];
    const int ch0 = 8 * (tidx & 127);
    float w[3][8];
#pragma unroll
    for (int k = 0; k < 3; ++k) { const f32x4 w0 = *(const GAS f32x4*)(cw + k * D + ch0), w1 = *(const GAS f32x4*)(cw + k * D + ch0 + 4);
        w[k][0] = w0.x; w[k][1] = w0.y; w[k][2] = w0.z; w[k][3] = w0.w; w[k][4] = w1.x; w[k][5] = w1.y; w[k][6] = w1.z; w[k][7] = w1.w; }
    TAIL_BEGIN_PUB(4, 10, MR / 32, 96, (chunk > 0 ? (32 * chunk - 2) >> 8 : 0), (32 * chunk) >> 8)
    if (32 * chunk < NPR) {
        const int R0 = 32 * chunk + 8 * (tidx >> 7), bq = R0 / TP, t0 = R0 - bq * TP;
        v4u win[10], bgq[8];
#pragma unroll
        for (int wi = 0; wi < 10; ++wi) win[wi] = (t0 - 2 + wi >= 0) ? *(const GAS v4u*)(CV + (size_t)(R0 - 2 + wi) * D + ch0) : (v4u){0u, 0u, 0u, 0u};
#pragma unroll
        for (int i = 0; i < 8; ++i) bgq[i] = *(const GAS v4u*)(BG + (size_t)(R0 + i) * D + ch0);
#pragma unroll
        for (int i = 0; i < 8; ++i) {
            float c8[8];
#pragma unroll
            for (int e = 0; e < 8; ++e) c8[e] = 0.f;
#pragma unroll
            for (int k = 0; k < 3; ++k) { const v4u q = win[i + k]; const float x[8] = {bflo(q.x), bfhi(q.x), bflo(q.y), bfhi(q.y), bflo(q.z), bfhi(q.z), bflo(q.w), bfhi(q.w)};
#pragma unroll
                for (int e = 0; e < 8; ++e) c8[e] = fmaf(w[k][e], x[e], c8[e]); }
            if (t0 + i >= TP - 2) { const v4u q = win[i + 2]; const float x[8] = {bflo(q.x), bfhi(q.x), bflo(q.y), bfhi(q.y), bflo(q.z), bfhi(q.z), bflo(q.w), bfhi(q.w)};
                GAS float* dst = (GAS float*)a.out + O_SCP + (size_t)(bq * 2 + (t0 + i - (TP - 2))) * D + ch0;
                *(GAS f32x4*)dst = (f32x4){x[0], x[1], x[2], x[3]}; *(GAS f32x4*)(dst + 4) = (f32x4){x[4], x[5], x[6], x[7]}; }
            const v4u g = bgq[i];
            v4u o; o.x = pk2(bflo(g.x) * c8[0], bfhi(g.x) * c8[1]); o.y = pk2(bflo(g.y) * c8[2], bfhi(g.y) * c8[3]);
            o.z = pk2(bflo(g.z) * c8[4], bfhi(g.z) * c8[5]); o.w = pk2(bflo(g.w) * c8[6], bfhi(g.w) * c8[7]);
            st16_wt(A3 + (size_t)(R0 + i) * D + ch0, o);
        }
    } else
#pragma unroll 4
    for (int i_ = 0; i_ < 8; ++i_) {
        const int R = 32 * chunk + (tidx >> 7) + 4 * i_;
        int t, T, bq; const bool is_sample = (R >= NPR);
        if (!is_sample) { bq = R / TP; t = R - bq * TP; T = TP; } else { bq = (R - NPR) >> 2; t = (R - NPR) & 3; T = 4; }
        float c8[8];
#pragma unroll
        for (int e = 0; e < 8; ++e) c8[e] = 0.f;
#pragma unroll
        for (int k = 0; k < 3; ++k) {
            const int tt = t - 2 + k; float x[8];
            if (tt >= 0) { const v4u q = *(const GAS v4u*)(CV + (size_t)(R - 2 + k) * D + ch0);
                x[0] = bflo(q.x); x[1] = bfhi(q.x); x[2] = bflo(q.y); x[3] = bfhi(q.y); x[4] = bflo(q.z); x[5] = bfhi(q.z); x[6] = bflo(q.w); x[7] = bfhi(q.w); }
            else if (is_sample) { const GAS float* sp = st + (size_t)(bq * 2 + (2 + tt)) * D + ch0; const f32x4 q0 = *(const GAS f32x4*)sp, q1 = *(const GAS f32x4*)(sp + 4);
                x[0] = q0.x; x[1] = q0.y; x[2] = q0.z; x[3] = q0.w; x[4] = q1.x; x[5] = q1.y; x[6] = q1.z; x[7] = q1.w; }
            else {
#pragma unroll
                for (int e = 0; e < 8; ++e) x[e] = 0.f; }
#pragma unroll
            for (int e = 0; e < 8; ++e) c8[e] = fmaf(w[k][e], x[e], c8[e]);
            if (k == 2 && t >= T - 2) {
                GAS float* dst = (GAS float*)a.out + (is_sample ? O_SCS : O_SCP) + (size_t)(bq * 2 + (t - (T - 2))) * D + ch0;
                *(GAS f32x4*)dst = (f32x4){x[0], x[1], x[2], x[3]}; *(GAS f32x4*)(dst + 4) = (f32x4){x[4], x[5], x[6], x[7]};
            }
        }
        const v4u g = *(const GAS v4u*)(BG + (size_t)R * D + ch0);
        v4u o; o.x = pk2(bflo(g.x) * c8[0], bfhi(g.x) * c8[1]); o.y = pk2(bflo(g.y) * c8[2], bfhi(g.y) * c8[3]);
        o.z = pk2(bflo(g.z) * c8[4], bfhi(g.z) * c8[5]); o.w = pk2(bflo(g.w) * c8[6], bfhi(g.w) * c8[7]);
        st16_wt(A3 + (size_t)R * D + ch0, o);
    }
    asm volatile("s_waitcnt vmcnt(0)" ::: "memory");
    TAIL_END
}

#define XB_TMO      128
#define XB_XCNT(j)  (256  + 64 * (j))
#define XB_XSUB(j)  (1280 + 64 * (j))
#define XB_XGEN(j)  (2304 + 64 * (j))
#define XB_TOP      3328
#define XB_TOPGEN   3392
#define XCD_BAR_WORDS 3456
#define XB_SPIN_CAP (1u << 18)

__device__ __forceinline__ unsigned xb_ld(unsigned* p)              { return __hip_atomic_load(p, __ATOMIC_RELAXED, __HIP_MEMORY_SCOPE_AGENT); }
__device__ __forceinline__ unsigned xb_add(unsigned* p, unsigned v) { return __hip_atomic_fetch_add(p, v, __ATOMIC_RELAXED, __HIP_MEMORY_SCOPE_AGENT); }
__device__ __forceinline__ unsigned xb_xcc_id() { return (unsigned)__builtin_amdgcn_s_getreg((3 << 11) | 20) & 0xFu; }
#define XB_SPIN(cond, bar) do { unsigned _sp = 0; while (cond) { __builtin_amdgcn_s_sleep(1); \
    if ((++_sp & 255u) == 0u) { if (xb_ld(&(bar)[XB_TMO])) break; if (_sp > XB_SPIN_CAP) { atomicAdd(&(bar)[XB_TMO], 1u); break; } } } } while (0)

struct XcdBarrier {
    unsigned* bar; unsigned x;
    volatile LAS unsigned* st;
};

__device__ __forceinline__ XcdBarrier xcd_barrier_post(unsigned* bar, volatile LAS unsigned* st, const int wave) {
    XcdBarrier b; b.bar = bar; b.x = xb_xcc_id(); b.st = st;
    if (wave == 0 && lane_id() == 0) (void)xb_add(&bar[XB_XCNT(b.x)], 1u);
    return b;
}
__device__ __forceinline__ void xcd_barrier_complete(unsigned* bar, unsigned x, unsigned& nloc, unsigned& nx) {
    const unsigned G = gridDim.x * gridDim.y * gridDim.z;
    unsigned sum, cnt, mine, sp = 0u;
    for (;;) {
        sum = 0u; cnt = 0u; mine = 0u;
#pragma unroll
        for (unsigned j = 0; j < 16; ++j) { const unsigned c = xb_ld(&bar[XB_XCNT(j)]); sum += c; cnt += (c > 0u) ? 1u : 0u; mine = (j == x) ? c : mine; }
        if (sum == G) break;
        __builtin_amdgcn_s_sleep(1);
        if ((++sp & 255u) == 0u) { if (xb_ld(&bar[XB_TMO])) break; if (sp > XB_SPIN_CAP) { atomicAdd(&bar[XB_TMO], 1u); break; } }
    }
    nloc = mine > 0u ? mine : 1u; nx = cnt > 0u ? cnt : 1u;
}

__device__ __forceinline__ void xcd_barrier(const XcdBarrier& b, const int wave) {
    asm volatile("s_waitcnt vmcnt(0)" ::: "memory");
    __syncthreads();
    if (wave == 0 && lane_id() == 0) {
        unsigned* bar = b.bar;
        __builtin_amdgcn_s_waitcnt(0);
        unsigned nloc = b.st[0], nx = b.st[1];
        if (nloc == 0u) { xcd_barrier_complete(bar, b.x, nloc, nx); b.st[0] = nloc; b.st[1] = nx; }
        const unsigned old = xb_add(&bar[XB_XSUB(b.x)], 1u);
        const unsigned gen = old / nloc;
        if (old + 1u == (gen + 1u) * nloc) {
            __builtin_amdgcn_fence(__ATOMIC_RELEASE, "agent");
            asm volatile("s_waitcnt vmcnt(0)" ::: "memory");
            const unsigned og = xb_add(&bar[XB_TOP], 1u);
            const unsigned tg = og / nx;
            if (og + 1u == (tg + 1u) * nx) xb_add(&bar[XB_TOPGEN], 1u);
            else XB_SPIN(xb_ld(&bar[XB_TOPGEN]) == tg, bar);
            __builtin_amdgcn_fence(__ATOMIC_ACQUIRE, "agent");
            xb_add(&bar[XB_XGEN(b.x)], 1u);
            asm volatile("s_waitcnt vmcnt(0)" ::: "memory");
        } else {
            XB_SPIN(xb_ld(&bar[XB_XGEN(b.x)]) == gen, bar);
            __builtin_amdgcn_fence(__ATOMIC_ACQUIRE, "agent");
            asm volatile("s_waitcnt vmcnt(0)" ::: "memory");
        }
    }
    __syncthreads();
}

__global__ void __launch_bounds__(512, 2) fwd_kernel(Args a) {
    extern __shared__ __attribute__((aligned(16))) unsigned char lds_raw[];
    LAS unsigned char* lds = (LAS unsigned char*)lds_raw;
    cg::grid_group grid = cg::this_grid();
    const int wave = __builtin_amdgcn_readfirstlane((int)threadIdx.x >> 6), lane = lane_id(), tid = wave * 64 + lane;
    unsigned char* ws = a.ws;
    bf16* HN = (bf16*)(ws + WS_HN); bf16* Y = (bf16*)(ws + WS_Y); bf16* R1 = (bf16*)(ws + WS_R1); bf16* R1B = (bf16*)(ws + WS_R1B);
    float* STATS = (float*)(ws + WS_STATS);
#define GEMM_STEP(BANK, Aptr, Bptr, NN, KK, MODE, OUT0, OUT1) GEMM_STEP_M(BANK, MP, Aptr, Bptr, NN, KK, MODE, OUT0, OUT1)
#define GEMM_STEP_M(BANK, MROWS, Aptr, Bptr, NN, KK, MODE, OUT0, OUT1) do { pg8::Gemm g; g.A = (Aptr); g.Bt = (Bptr); g.M = (MROWS); g.N = (NN); g.K = (KK); g.lda = (KK); g.ldb = (KK); g.kmode = 0; g.ksl = 1; \
        EpiGen E; E.mode = (MODE); E.O0 = (OUT0); E.O1 = (OUT1); E.stats = STATS; E.XC = nullptr; E.pa = nullptr; E.pb = nullptr; E.pl = nullptr; E.ksl = 1; \
        PubOrder S; S.init((MROWS), (NN), (int)gridDim.x, (int)blockIdx.x, (BANK) == 7 ? 8 : 1); S.cnt = ctl + CW_CNT + (BANK) * CW_BANK; \
        if ((BANK) == 7) pg8::gemm_phase<EpiGen, pg8::StaticOrder, true, true>(lds, g, S, E, wave); else pg8::gemm_phase<EpiGen, PubOrder, true, true>(lds, g, S, E, wave); } while (0)
    volatile LAS unsigned* st = (volatile LAS unsigned*)(lds + 131072 + 64);
    if (tid < 2) st[tid] = 0u;
    unsigned* barw = (unsigned*)ws;
    unsigned* ctl = (unsigned*)ws;
    volatile LAS unsigned* bc = (volatile LAS unsigned*)(lds + 131072 + 128);
#define GU_STEP(RBANK, Bptr, GREADY, GNEED) do { pg8::Gemm g; g.A = HN; g.Bt = (Bptr); g.M = MP; g.N = 5632; g.K = 1024; g.lda = 1024; g.ldb = 1024; g.kmode = 0; g.ksl = 1; \
        EpiGen E; E.mode = 1; E.O0 = R1; E.O1 = nullptr; E.stats = STATS; E.XC = nullptr; E.pa = nullptr; E.pb = nullptr; E.pl = nullptr; E.ksl = 1; \
        CountedOrder S; S.init(MP, 5632, (int)gridDim.x, (int)blockIdx.x, 4); S.ready = ctl + CW_CNT + (RBANK) * CW_BANK; S.need = 8u; S.need66 = 4u; S.gready = (GREADY); S.gneed = (GNEED); S.wv = wave; S.gcnt = nullptr; S.cnt = ctl + CW_CNT + 7 * CW_BANK; \
        pg8::gemm_phase<EpiGen, CountedOrder, true, true>(lds, g, S, E, wave); } while (0)

#define DOWNM_STEP(BANK, Bptr, GUNEED, GCNT) do { pg8::Gemm g; g.A = R1; g.Bt = (Bptr); g.M = MAINR; g.N = 1024; g.K = DFF; g.lda = DFF; g.ldb = DFF; g.kmode = 0; g.ksl = 1; \
        EpiGen E; E.mode = 3; E.O0 = Y; E.O1 = nullptr; E.stats = STATS; E.XC = nullptr; E.pa = nullptr; E.pb = nullptr; E.pl = nullptr; E.ksl = 1; \
        CountedOrder S; S.init(MAINR, 1024, (int)gridDim.x, (int)blockIdx.x, 1); S.ready = ctl + CW_CNT + 7 * CW_BANK; S.need = (GUNEED); S.need66 = (GUNEED); S.gready = nullptr; S.gneed = 0u; S.wv = wave; S.gcnt = (GCNT); S.cnt = ctl + CW_CNT + (BANK) * CW_BANK; \
        pg8::gemm_phase<EpiGen, CountedOrder, true, true>(lds, g, S, E, wave); } while (0)
#define DOWNX_STEP(BANK, Bptr, GUNEED, GCNT) do { int kx_ = 256; asm volatile("" : "+s"(kx_)); \
        pg8::Gemm g; g.A = R1; g.Bt = (Bptr); g.M = MP; g.N = 1024; g.K = kx_; g.lda = DFF; g.ldb = DFF; g.kmode = 2; g.ksl = 11; \
        EpiGen E; E.mode = 5; E.O0 = Y; E.O1 = (bf16*)(ws + WS_Y2); E.stats = STATS; E.XC = nullptr; E.pa = nullptr; E.pb = nullptr; E.pl = nullptr; E.ksl = 11; \
        ExtraOrderC S; S.init(MP, 1024, (int)gridDim.x, (int)blockIdx.x, 1); S.ready = ctl + CW_CNT + 7 * CW_BANK; S.need = (GUNEED); S.need66 = (GUNEED); S.gready = nullptr; S.gneed = 0u; S.wv = wave; S.gcnt = (GCNT); S.cnt = ctl + CW_CNT + (BANK) * CW_BANK; S.ksl = 11; \
        pg8::gemm_phase<EpiGen, ExtraOrderC, true, true>(lds, g, S, E, wave); } while (0)
#define OUT_STEP(BANK, Bptr, RBANK, NEEDP, NEED66P) do { { pg8::Gemm g; g.A = HN; g.Bt = (Bptr); g.M = MAINR; g.N = 1024; g.K = 1024; g.lda = 1024; g.ldb = 1024; g.kmode = 0; g.ksl = 1; \
        EpiGen E; E.mode = 3; E.O0 = Y; E.O1 = nullptr; E.stats = STATS; E.XC = nullptr; E.pa = nullptr; E.pb = nullptr; E.pl = nullptr; E.ksl = 1; \
        CountedOrder S; S.init(MAINR, 1024, (int)gridDim.x, (int)blockIdx.x, 1); S.ready = ctl + CW_CNT + (RBANK) * CW_BANK; S.need = (NEEDP); S.need66 = (NEED66P); S.gready = nullptr; S.gneed = 0u; S.wv = wave; S.gcnt = nullptr; S.cnt = ctl + CW_CNT + (BANK) * CW_BANK; \
        pg8::gemm_phase<EpiGen, CountedOrder, true, true>(lds, g, S, E, wave); } \
      { int kx_ = 256; asm volatile("" : "+s"(kx_)); \
        pg8::Gemm g; g.A = HN; g.Bt = (Bptr); g.M = MP; g.N = 1024; g.K = kx_; g.lda = 1024; g.ldb = 1024; g.kmode = 2; g.ksl = 4; \
        EpiGen E; E.mode = 5; E.O0 = Y; E.O1 = (bf16*)(ws + WS_Y2); E.stats = STATS; E.XC = nullptr; E.pa = nullptr; E.pb = nullptr; E.pl = nullptr; E.ksl = 4; \
        ExtraOrderC S; S.init(MP, 1024, (int)gridDim.x, (int)blockIdx.x, 1); S.ready = ctl + CW_CNT + (RBANK) * CW_BANK; S.need = (NEEDP); S.need66 = (NEED66P); S.gready = nullptr; S.gneed = 0u; S.wv = wave; S.gcnt = nullptr; S.cnt = ctl + CW_CNT + (BANK) * CW_BANK; S.ksl = 4; \
        pg8::gemm_phase<EpiGen, ExtraOrderC, true, true>(lds, g, S, E, wave); } } while (0)
#define EXTRA_STEP(BANK, Aptr, Bptr, KTOT, NSL) do { int kx_ = 256; asm volatile("" : "+s"(kx_));     \
        pg8::Gemm g; g.A = (Aptr); g.Bt = (Bptr); g.M = MP; g.N = 1024; g.K = kx_; g.lda = (KTOT); g.ldb = (KTOT); g.kmode = 2; g.ksl = (NSL); \
        EpiGen E; E.mode = 5; E.O0 = Y; E.O1 = (bf16*)(ws + WS_Y2); E.stats = STATS; E.XC = nullptr; E.pa = nullptr; E.pb = nullptr; E.pl = nullptr; E.ksl = (NSL); \
        ExtraOrder S; S.init(MP, 1024, (int)gridDim.x, (int)blockIdx.x, 1); S.cnt = ctl + CW_CNT + (BANK) * CW_BANK; S.ksl = (NSL); \
        pg8::gemm_phase<EpiGen, ExtraOrder, true, true>(lds, g, S, E, wave); } while (0)
    __syncthreads();
    XcdBarrier bar = xcd_barrier_post(barw, st, wave);
#define GSYNC() xcd_barrier(bar, wave)
    if (a.ws == nullptr) grid.sync();
    p0_phase(a, lds, wave, lane); GSYNC();
    GEMM_STEP(0, HN, (const bf16*)(ws + WS_WIN0), 2048, 1024, 0, R1, R1B);
    rgconv_tail(a, ctl, bc, wave); p0b_tail(a, lds, wave, lane, ctl, bc); GSYNC();
    { pg8::Gemm g; g.A = HN; g.Bt = (const bf16*)(ws + WS_WG); g.M = MP; g.N = 2048; g.K = 256; g.lda = 1024; g.ldb = 256; g.kmode = 1; g.ksl = 1;
      EpiGen E; E.mode = 4; E.O0 = Y; E.O1 = R1B; E.stats = STATS; E.ksl = 1; E.XC = HN; E.pa = a.in[14]; E.pb = a.in[16]; E.pl = a.in[17];
      PubOrder S; S.init(MP, 2048, (int)gridDim.x, (int)blockIdx.x, 1); S.cnt = ctl + CW_CNT + 1 * CW_BANK;
      pg8::gemm_phase<EpiGen, PubOrder, true, true>(lds, g, S, E, wave); }
    lru_scan1_tail(a, lds, ctl, bc, wave);
    lru_scan2_phase(a, lds, wave, ctl);
    OUT_STEP(2, (const bf16*)(ws + WS_WOUT0), 12, 16u, 8u);
    norm_res_tail<true, 4, 8>(a, a.in[7], a.in[8], wave, lane, ctl, 2, bc);
    GU_STEP(8, (const bf16*)(ws + WS_WGU), ctl + CW_CNT + 12 * CW_BANK + 64 * 100, 1064u);
    DOWNM_STEP(3, (const bf16*)(ws + WS_WD), 176u, ctl + CW_CNT + 3 * CW_BANK + 64 * 100); DOWNX_STEP(3, (const bf16*)(ws + WS_WD), 176u, ctl + CW_CNT + 3 * CW_BANK + 64 * 100);
    norm_res_tail<false, 11, 11>(a, a.in[9], a.in[6] + D, wave, lane, ctl, 3, bc);
    { pg8::Gemm g; g.A = HN; g.Bt = (const bf16*)(ws + WS_WSCIN); g.M = MP; g.N = 3072; g.K = 1024; g.lda = 1024; g.ldb = 1024; g.kmode = 0; g.ksl = 1;
      EpiGen E; E.mode = 2; E.O0 = R1; E.O1 = R1B; E.stats = STATS; E.XC = nullptr; E.pa = nullptr; E.pb = nullptr; E.pl = nullptr; E.ksl = 1;
      CountedOrder S; S.init(MP, 3072, (int)gridDim.x, (int)blockIdx.x, 1); S.ready = ctl + CW_CNT + 11 * CW_BANK; S.need = 8u; S.need66 = 4u;
      S.gready = ctl + CW_CNT + 3 * CW_BANK + 64 * 100; S.gneed = (256u + 132u) * 8u;
      S.wv = wave; S.gcnt = nullptr; S.cnt = ctl + CW_CNT + 4 * CW_BANK;
      pg8::gemm_phase<EpiGen, CountedOrder, true, true>(lds, g, S, E, wave); }
    sconv_tail(a, ctl, bc, wave);
    OUT_STEP(5, (const bf16*)(ws + WS_WSCOUT), 10, 8u, 4u);
    norm_res_tail<false, 4, 9>(a, a.in[7] + D, a.in[8] + D, wave, lane, ctl, 5, bc);
    GU_STEP(9, (const bf16*)(ws + WS_WGU) + (size_t)5632 * 1024, ctl + CW_CNT + 10 * CW_BANK + 64 * 100, 532u);
    DOWNM_STEP(6, (const bf16*)(ws + WS_WD) + (size_t)1024 * DFF, 352u, nullptr); DOWNX_STEP(6, (const bf16*)(ws + WS_WD) + (size_t)1024 * DFF, 352u, nullptr);
    norm_res_tail<false, 11, -1>(a, a.in[9] + D, nullptr, wave, lane, ctl, 6, bc);
}

extern "C" void kernel_launch(void* const* d_in, const int* in_sizes, int n_in, void* d_out, int out_size, void* d_ws, size_t ws_size, hipStream_t stream) {
    static int grid = 0;
    if (grid == 0) {
        if (n_in != 25 || ws_size < WS_END) { fprintf(stderr, "kernel_launch: unexpected n_in %d / ws_size %zu\n", n_in, ws_size); grid = -1; return; }
        int dev = 0, cus = 0, per_cu = 0;
        hipGetDevice(&dev);
        hipDeviceGetAttribute(&cus, hipDeviceAttributeMultiprocessorCount, dev);
        if (hipFuncSetAttribute((const void*)fwd_kernel, hipFuncAttributeMaxDynamicSharedMemorySize, LDS_BYTES) != hipSuccess) { fprintf(stderr, "kernel_launch: hipFuncSetAttribute failed\n"); grid = -1; return; }
        if (hipOccupancyMaxActiveBlocksPerMultiprocessor(&per_cu, (const void*)fwd_kernel, 512, LDS_BYTES) != hipSuccess || per_cu < 1) { fprintf(stderr, "kernel_launch: occupancy query failed (%d)\n", per_cu); (void)hipGetLastError(); per_cu = 1; }
        grid = cus * per_cu;
        fprintf(stderr, "kernel_launch: %d CUs x %d = grid %d\n", cus, per_cu, grid);
    }
    if (grid < 0) return;
    Args a{};
    for (int i = 0; i < 25; ++i) a.in[i] = (const float*)d_in[i];
    a.out = (float*)d_out; a.ws = (unsigned char*)d_ws;
    if (hipMemsetAsync(d_ws, 0, (size_t)CTL_WORDS * 4, stream) != hipSuccess) { fprintf(stderr, "kernel_launch: memset failed\n"); return; }
    void* args[] = {&a};
    hipError_t e = hipLaunchCooperativeKernel((const void*)fwd_kernel, dim3(grid), dim3(512), args, LDS_BYTES, stream);
    if (e != hipSuccess) fprintf(stderr, "kernel_launch: cooperative launch failed: %s (grid %d)\n", hipGetErrorString(e), grid);
}
```

```cpp
#include <hip/hip_runtime.h>
#include <hip/hip_cooperative_groups.h>
#include <cstdio>
#include <cstdint>
namespace cg = cooperative_groups;
__device__ __forceinline__ int lane_id() { return (int)__builtin_amdgcn_mbcnt_hi(~0u, __builtin_amdgcn_mbcnt_lo(~0u, 0u)); }

namespace pg8 {
#define PG8_LAS __attribute__((address_space(3)))
typedef unsigned short bf16_t;
typedef short bf16x8 __attribute__((ext_vector_type(8)));
typedef float f32x4 __attribute__((ext_vector_type(4)));
typedef unsigned u32x4 __attribute__((ext_vector_type(4)));
constexpr int BM = 256, BK = 64, HALF = 128, HTB = HALF * BK * 2  , STAGE_BYTES = 8 * HTB, NXCD = 8, WGM = 8;

__host__ __device__ __forceinline__ int lds_byte(int r, int c) { const int st = (r >> 4) * 2 + (c >> 5), rr = r & 15, cc = c & 31, ob = rr * 64 + cc * 2; return st * 1024 + (ob ^ (((ob >> 9) & 1) << 5)); }
__host__ __device__ __forceinline__ void stage_rc(int b, int& R, int& C) { const int st = b / 1024, sb = b % 1024, swz = sb ^ (((sb >> 9) & 1) << 5); R = (st >> 1) * 16 + swz / 64; C = (st & 1) * 32 + (swz % 64) / 2; }
__host__ __device__ __forceinline__ int perm32(int rho) { const int n = rho >> 4, i = rho & 15; return 8 * (i >> 2) + 4 * n + (i & 3); }

struct Unit { int pm, pn; };
struct Gemm { const bf16_t* A; const bf16_t* Bt; int M, N, K, lda, ldb, kmode, ksl; };

struct StaticOrder {
    int nM, nN, nwg, G, c, wgm;
    __host__ __device__ void init(int M, int N, int G_, int c_, int wgm_ = WGM) { nM = M / BM; nN = N / BM; nwg = nM * nN; G = G_; c = c_; wgm = wgm_; }
    __host__ __device__ bool next(int i, Unit& u) const {
        const long L = (long)i * G + c; if (L >= nwg) return false;
        int wgid = (int)L; { const int q = nwg / NXCD, r = nwg % NXCD, xcd = wgid % NXCD, off = wgid / NXCD; wgid = (xcd < r ? xcd * (q + 1) : r * (q + 1) + (xcd - r) * q) + off; }
        const int nig = wgm * nN, gid = wgid / nig, fm = gid * wgm, gsz = (nM - fm) < wgm ? (nM - fm) : wgm;
        u.pm = fm + ((wgid % nig) % gsz); u.pn = (wgid % nig) / gsz; return true;
    }
    __device__ __forceinline__ void a_ready(const Unit&) const {}
    __device__ __forceinline__ void done(const Unit&) const {}
};

__device__ __forceinline__ unsigned cvt_pk_bf16(float lo, float hi) { unsigned r; asm volatile("v_cvt_pk_bf16_f32 %0, %1, %2" : "=v"(r) : "v"(lo), "v"(hi)); return r; }

template <class Epi, class Sched, bool ALIGN_EPI = false, bool SP2 = false>
__device__ __forceinline__ void gemm_phase(PG8_LAS unsigned char* lds, const Gemm g, const Sched& S, const Epi& E, const int wave_s) {
    int tid_ = wave_s * 64 + lane_id(); asm volatile("" : "+v"(tid_));
    const int tid = tid_, wid = __builtin_amdgcn_readfirstlane(tid >> 6), lane = tid & 63, wr = wid >> 2, wc = wid & 3, fr = lane & 15, fq = lane >> 4;
    const int K = g.K, nt = K / BK;
    unsigned voffA[2], voffB[2];
#pragma unroll
    for (int i = 0; i < 2; ++i) { int R, C; stage_rc(tid * 16 + i * 8192, R, C); const int Rb = Epi::PERM ? ((R & ~31) + perm32(R & 31)) : R;
        voffA[i] = (unsigned)(R * g.lda + C) * 2u; voffB[i] = (unsigned)(Rb * g.ldb + C) * 2u; }
    const size_t kstep = (size_t)(BK * 2);
    const size_t hstepB = (size_t)HALF * g.ldb * 2, hstepA = (size_t)HALF * g.lda * 2;
    const size_t tstepB = 2 * hstepB, tstepA = 2 * hstepA;
    const unsigned ldsw = (unsigned)wid * 1024u;
    const int aoff = lds_byte(wr * 64 + fr, fq * 8), boff = lds_byte(wc * 32 + fr, fq * 8);
#define PG8_SA(b, h) (((b) * 2 + (h)) * HTB)
#define PG8_SB(b, h) ((4 + (b) * 2 + (h)) * HTB)
#define PG8_STAGE(bufoff, gbase, voff) do { _Pragma("unroll") for (int _i = 0; _i < 2; ++_i) \
        __builtin_amdgcn_global_load_lds((const unsigned*)((const char*)(gbase) + (voff)[_i]), (PG8_LAS unsigned*)(lds + (bufoff) + ldsw + _i * 8192), 16, 0, 0); } while (0)
#define PG8_LDA(dst, b, h) do { _Pragma("unroll") for (int m = 0; m < 4; ++m) _Pragma("unroll") for (int k = 0; k < 2; ++k) dst[m][k] = *(const PG8_LAS bf16x8*)(lds + PG8_SA(b, h) + aoff + m * 2048 + k * 1024); } while (0)
#define PG8_LDB(dst, b, h) do { _Pragma("unroll") for (int n = 0; n < 2; ++n) _Pragma("unroll") for (int k = 0; k < 2; ++k) dst[n][k] = *(const PG8_LAS bf16x8*)(lds + PG8_SB(b, h) + boff + n * 2048 + k * 1024); } while (0)
#define PG8_MMA(ai, bj, At, Bt) do { __builtin_amdgcn_s_setprio(1); _Pragma("unroll") for (int m = 0; m < 4; ++m) _Pragma("unroll") for (int n = 0; n < 2; ++n) _Pragma("unroll") for (int k = 0; k < 2; ++k) \
        acc[ai][bj][m][n] = __builtin_amdgcn_mfma_f32_16x16x32_bf16(Bt[n][k], At[m][k], acc[ai][bj][m][n], 0, 0, 0); __builtin_amdgcn_s_setprio(0); } while (0)
#define PG8_WAIT_V(n) asm volatile("s_waitcnt vmcnt(" #n ")" ::: "memory")
#define PG8_WAIT_L(n) asm volatile("s_waitcnt lgkmcnt(" #n ")" ::: "memory")
#define PG8_BAR __builtin_amdgcn_s_barrier()
#define PG8_SCHED __builtin_amdgcn_sched_barrier(0)
    Unit cur, nxt; int ui = 0;
    if (!S.next(0, cur)) return;
    f32x4 acc[2][2][4][2];
#pragma unroll
    for (int a = 0; a < 2; ++a)
#pragma unroll
        for (int b = 0; b < 2; ++b)
#pragma unroll
            for (int m = 0; m < 4; ++m)
#pragma unroll
                for (int n = 0; n < 2; ++n) acc[a][b][m][n] = (f32x4){0.f, 0.f, 0.f, 0.f};
    bf16x8 At[4][2], B0[2][2], B1[2][2];
    const char* cA = (const char*)g.A + (size_t)cur.pm * tstepA + (g.kmode == 1 ? (size_t)(cur.pn >> 1) * 512 : g.kmode == 2 ? (size_t)(cur.pn % g.ksl) * (size_t)(K * 2) : (size_t)0); const char* cB = (const char*)g.Bt + (g.kmode == 2 ? (size_t)(cur.pn / g.ksl) * tstepB + (size_t)(cur.pn % g.ksl) * (size_t)(K * 2) : (size_t)cur.pn * tstepB);
    S.a_ready(cur);
    if constexpr (SP2) {
        PG8_STAGE(PG8_SB(0, 0), cB, voffB); PG8_STAGE(PG8_SB(0, 1), cB + hstepB, voffB); PG8_STAGE(PG8_SA(0, 0), cA, voffA); PG8_STAGE(PG8_SA(0, 1), cA + hstepA, voffA);
        if (wr == 1) PG8_BAR;
        PG8_WAIT_V(2); PG8_BAR;
        PG8_STAGE(PG8_SB(1, 0), cB + kstep, voffB); PG8_STAGE(PG8_SA(1, 0), cA + kstep, voffA); PG8_STAGE(PG8_SB(1, 1), cB + hstepB + kstep, voffB);
        PG8_WAIT_V(6); PG8_BAR;
    } else {
        PG8_STAGE(PG8_SB(0, 0), cB, voffB); PG8_STAGE(PG8_SA(0, 0), cA, voffA); PG8_STAGE(PG8_SB(0, 1), cB + hstepB, voffB); PG8_STAGE(PG8_SA(0, 1), cA + hstepA, voffA);
        if (wr == 1) PG8_BAR;
        PG8_WAIT_V(4); PG8_BAR;
        PG8_STAGE(PG8_SB(1, 0), cB + kstep, voffB); PG8_STAGE(PG8_SA(1, 0), cA + kstep, voffA); PG8_STAGE(PG8_SB(1, 1), cB + hstepB + kstep, voffB);
        PG8_WAIT_V(6); PG8_BAR;
    }
    for (;;) {
        const bool has_next = S.next(ui + 1, nxt);
        const char* nA = has_next ? (const char*)g.A + (size_t)nxt.pm * tstepA + (g.kmode == 1 ? (size_t)(nxt.pn >> 1) * 512 : g.kmode == 2 ? (size_t)(nxt.pn % g.ksl) * (size_t)(K * 2) : (size_t)0) : cA; const char* nB = has_next ? (const char*)g.Bt + (g.kmode == 2 ? (size_t)(nxt.pn / g.ksl) * tstepB + (size_t)(nxt.pn % g.ksl) * (size_t)(K * 2) : (size_t)nxt.pn * tstepB) : cB;
        for (int t = 0; t < nt; t += 2) {
            const bool last = (t == nt - 2);
            const char* a1 = cA + (size_t)(t + 1) * kstep;
            const char* a2 = last ? nA : cA + (size_t)(t + 2) * kstep; const char* b2 = last ? nB : cB + (size_t)(t + 2) * kstep;
            const char* a3 = a2 + kstep; const char* b3 = b2 + kstep;
            if (last && has_next) S.a_ready(nxt);
            if constexpr (SP2) {
            PG8_LDB(B0, 0, 0); PG8_LDB(B1, 0, 1); PG8_SCHED; PG8_LDA(At, 0, 0); PG8_STAGE(PG8_SA(1, 1), a1 + hstepA, voffA);
            PG8_WAIT_V(8); PG8_WAIT_L(0); PG8_BAR; PG8_MMA(0, 0, At, B0); PG8_MMA(0, 1, At, B1); PG8_BAR; PG8_SCHED;
            PG8_LDA(At, 0, 1); PG8_STAGE(PG8_SB(0, 0), b2, voffB); PG8_STAGE(PG8_SB(0, 1), b2 + hstepB, voffB); PG8_STAGE(PG8_SA(0, 0), a2, voffA);
            PG8_WAIT_V(8); PG8_WAIT_L(0); PG8_BAR; PG8_MMA(1, 0, At, B0); PG8_MMA(1, 1, At, B1); PG8_BAR; PG8_SCHED;
            PG8_LDB(B0, 1, 0); PG8_LDB(B1, 1, 1); PG8_SCHED; PG8_LDA(At, 1, 0); PG8_STAGE(PG8_SA(0, 1), a2 + hstepA, voffA);
            PG8_WAIT_V(8); PG8_WAIT_L(0); PG8_BAR; PG8_MMA(0, 0, At, B0); PG8_MMA(0, 1, At, B1); PG8_BAR; PG8_SCHED;
            PG8_LDA(At, 1, 1); PG8_STAGE(PG8_SB(1, 0), b3, voffB); PG8_STAGE(PG8_SB(1, 1), b3 + hstepB, voffB); PG8_STAGE(PG8_SA(1, 0), a3, voffA);
            PG8_WAIT_V(8); PG8_WAIT_L(0); PG8_BAR; PG8_MMA(1, 0, At, B0); PG8_MMA(1, 1, At, B1); PG8_BAR; PG8_SCHED;
            } else {
            PG8_LDB(B0, 0, 0); PG8_SCHED; PG8_LDA(At, 0, 0); PG8_STAGE(PG8_SA(1, 1), a1 + hstepA, voffA);
            PG8_WAIT_L(8); PG8_BAR; PG8_WAIT_L(0); PG8_MMA(0, 0, At, B0); PG8_BAR; PG8_SCHED;
            PG8_LDB(B1, 0, 1); PG8_STAGE(PG8_SB(0, 0), b2, voffB);
            PG8_BAR; PG8_WAIT_L(0); PG8_MMA(0, 1, At, B1); PG8_BAR;
            PG8_LDA(At, 0, 1); PG8_STAGE(PG8_SA(0, 0), a2, voffA);
            PG8_BAR; PG8_WAIT_L(0); PG8_MMA(1, 0, At, B0); PG8_BAR; PG8_SCHED;
            PG8_STAGE(PG8_SB(0, 1), b2 + hstepB, voffB);
            PG8_WAIT_V(6); PG8_BAR; PG8_MMA(1, 1, At, B1); PG8_BAR;
            PG8_LDB(B0, 1, 0); PG8_SCHED; PG8_LDA(At, 1, 0); PG8_STAGE(PG8_SA(0, 1), a2 + hstepA, voffA);
            PG8_WAIT_L(8); PG8_BAR; PG8_WAIT_L(0); PG8_MMA(0, 0, At, B0); PG8_BAR; PG8_SCHED;
            PG8_LDB(B1, 1, 1); PG8_STAGE(PG8_SB(1, 0), b3, voffB);
            PG8_BAR; PG8_WAIT_L(0); PG8_MMA(0, 1, At, B1); PG8_BAR;
            PG8_LDA(At, 1, 1); PG8_STAGE(PG8_SA(1, 0), a3, voffA);
            PG8_BAR; PG8_WAIT_L(0); PG8_MMA(1, 0, At, B0); PG8_BAR; PG8_SCHED;
            PG8_STAGE(PG8_SB(1, 1), b3 + hstepB, voffB);
            PG8_WAIT_V(6); PG8_BAR; PG8_MMA(1, 1, At, B1); PG8_BAR;
            }
        }
        if constexpr (ALIGN_EPI) { if (wr == 0) PG8_BAR; }
        if constexpr (!Epi::AFTER_DRAIN) { E(acc, cur, wr, wc, fr, fq); S.done(cur); }
        if (!has_next) break;
#pragma unroll
        for (int a = 0; a < 2; ++a)
#pragma unroll
            for (int b = 0; b < 2; ++b)
#pragma unroll
                for (int m = 0; m < 4; ++m)
#pragma unroll
                    for (int n = 0; n < 2; ++n) acc[a][b][m][n] = (f32x4){0.f, 0.f, 0.f, 0.f};
        cur = nxt; cA = nA; cB = nB; ++ui;
        if constexpr (ALIGN_EPI) { if (wr == 1) PG8_BAR; }
    }
    PG8_WAIT_V(0);
    if constexpr (!ALIGN_EPI) { if (wr == 0) PG8_BAR; }
    PG8_BAR;
    if constexpr (Epi::AFTER_DRAIN) { E.fused(acc, cur, wr, wc, fr, fq, lds, wid, lane); S.done(cur); }
#undef PG8_SA
#undef PG8_SB
#undef PG8_STAGE
#undef PG8_LDA
#undef PG8_LDB
#undef PG8_MMA
#undef PG8_WAIT_V
#undef PG8_WAIT_L
#undef PG8_BAR
#undef PG8_SCHED
}
}


constexpr int D = 1024, DFF = 2816, TP = 2064  , NPR = 8 * TP  , NSM = 512, MR = NPR + NSM  , MP = 17152  ;
constexpr float EPS = 1e-6f;
constexpr int MAINR = 16384  , XROWS = MP - MAINR  ;
constexpr size_t O_YP = 0, O_YS = 16777216, O_RCP = 17301504, O_RHP = 17326080, O_SCP = 17334272, O_RCS = 17350656, O_RHS = 17743872, O_SCS = 17874944;
constexpr size_t MiB = 1u << 20;
constexpr size_t WS_WIN0 = 1 * MiB, WS_WG = 5 * MiB, WS_WOUT0 = 6 * MiB, WS_WSCIN = 8 * MiB, WS_WSCOUT = 14 * MiB, WS_WGU = 16 * MiB, WS_WD = 38 * MiB;
constexpr size_t WS_XMETA = 49 * MiB, WS_STATS = 50 * MiB, WS_AGG = 52 * MiB, WS_HN = 56 * MiB, WS_Y = 90 * MiB, WS_R1 = 124 * MiB, WS_R1B = 158 * MiB, WS_Y2 = 218 * MiB, WS_END = 252 * MiB;
static_assert(WS_HN + (size_t)MP * D * 2 <= WS_Y && WS_Y + (size_t)MP * D * 2 <= WS_R1 && WS_R1 + (size_t)MP * D * 2 <= WS_R1B && WS_R1 + (size_t)MP * DFF * 2 <= WS_Y2 && WS_Y2 + (size_t)MP * D * 2 <= WS_END, "ws map");
constexpr int LDS_BYTES = 135168;

#define GAS __attribute__((address_space(1)))
#define LAS __attribute__((address_space(3)))
typedef unsigned short bf16;
typedef unsigned v4u __attribute__((ext_vector_type(4)));
typedef unsigned v2u __attribute__((ext_vector_type(2)));
typedef float f32x4 __attribute__((ext_vector_type(4)));
typedef float f32x16 __attribute__((ext_vector_type(16)));
typedef short bf16x8 __attribute__((ext_vector_type(8)));

struct Args { const float* in[25]; float* out; unsigned char* ws; };

__device__ __forceinline__ unsigned pk2(float lo, float hi) { return pg8::cvt_pk_bf16(lo, hi); }
__device__ __forceinline__ float bflo(unsigned w) { return __uint_as_float(w << 16); }
__device__ __forceinline__ float bfhi(unsigned w) { return __uint_as_float(w & 0xffff0000u); }
__device__ __forceinline__ float sigmoidf_(float x) { return __builtin_amdgcn_rcpf(1.0f + __expf(-x)); }
__device__ __forceinline__ float gelu_tanh(float x) { const float z = 1.5957691216f * (x + 0.044715f * x * x * x); return x * sigmoidf_(z); }
__device__ __forceinline__ float silu_(float x) { return x * sigmoidf_(x); }
__device__ __forceinline__ float wave_sum(float v) {
#pragma unroll
    for (int o = 1; o < 64; o <<= 1) v += __shfl_xor(v, o);
    return v;
}
#define LDS_WAIT() asm volatile("s_waitcnt lgkmcnt(0)" ::: "memory")

__device__ __forceinline__ void st16_wt(bf16* p, v4u w) { asm volatile("global_store_dwordx4 %0, %1, off sc0 sc1\n\ts_nop 1" :: "v"((GAS v4u*)p), "v"(w) : "memory"); }
__device__ __forceinline__ void st16f_wt(GAS f32x4* p, f32x4 w) { asm volatile("global_store_dwordx4 %0, %1, off sc0 sc1\n\ts_nop 1" :: "v"(p), "v"(w) : "memory"); }
__device__ __forceinline__ void st8_wt(GAS v2u* p, v2u w) { asm volatile("global_store_dwordx2 %0, %1, off sc0 sc1\n\ts_nop 1" :: "v"(p), "v"(w) : "memory"); }
__device__ __forceinline__ void st4_wt(float* p, float v) { asm volatile("global_store_dword %0, %1, off sc0 sc1\n\ts_nop 1" :: "v"((GAS float*)p), "v"(v) : "memory"); }
struct EpiGen {
    static constexpr bool PERM = true, AFTER_DRAIN = false;
    int mode;
    bf16* O0; bf16* O1; float* stats;
    const bf16* XC; const float* pa; const float* pb; const float* pl;
    int ksl;
    __device__ __forceinline__ void operator()(const pg8::f32x4 (&acc)[2][2][4][2], const pg8::Unit& u, int wr, int wc, int fr, int fq) const {
        const int row0 = u.pm * 256 + wr * 64 + fr;
        if (mode == 5) {
            const int ks = u.pn % ksl, pnr = u.pn / ksl;
            bf16* base = O1 + ((size_t)ks * XROWS + (size_t)(row0 - MAINR)) * D + pnr * 256 + wc * 32 + 8 * fq;
#pragma unroll
            for (int ai = 0; ai < 2; ++ai)
#pragma unroll
                for (int m = 0; m < 4; ++m) {
                    bf16* rowp = base + (size_t)(ai * 128 + m * 16) * D;
#pragma unroll
                    for (int bj = 0; bj < 2; ++bj) { const pg8::f32x4 v0 = acc[ai][bj][m][0], v1 = acc[ai][bj][m][1];
                        v4u w; w.x = pk2(v0[0], v0[1]); w.y = pk2(v0[2], v0[3]); w.z = pk2(v1[0], v1[1]); w.w = pk2(v1[2], v1[3]);
                        st16_wt(rowp + bj * 128, w); }
                }
        } else if (mode == 4) {
            const int c0 = 256 * (u.pn >> 1) + 128 * (u.pn & 1) + wc * 32 + 8 * fq;
            float bA[8], bX[8], sp8[8];
            { const f32x4 a0 = *(const GAS f32x4*)(pa + c0), a1 = *(const GAS f32x4*)(pa + c0 + 4), b0 = *(const GAS f32x4*)(pb + c0), b1 = *(const GAS f32x4*)(pb + c0 + 4), l0 = *(const GAS f32x4*)(pl + c0), l1 = *(const GAS f32x4*)(pl + c0 + 4);
#pragma unroll
                for (int i = 0; i < 4; ++i) { bA[i] = a0[i]; bA[4 + i] = a1[i]; bX[i] = b0[i]; bX[4 + i] = b1[i]; sp8[i] = -8.0f * log1pf(__expf(-l0[i])); sp8[4 + i] = -8.0f * log1pf(__expf(-l1[i])); } }
#pragma unroll
            for (int ai = 0; ai < 2; ++ai)
#pragma unroll
                for (int m = 0; m < 4; ++m) {
                    const size_t off = (size_t)(row0 + ai * 128 + m * 16) * D + c0;
                    const v4u xq = *(const GAS v4u*)(XC + off);
                    float xc[8] = {bflo(xq.x), bfhi(xq.x), bflo(xq.y), bfhi(xq.y), bflo(xq.z), bfhi(xq.z), bflo(xq.w), bfhi(xq.w)};
                    float om[8], uu[8];
#pragma unroll
                    for (int n = 0; n < 2; ++n)
#pragma unroll
                        for (int i = 0; i < 4; ++i) { const int e = 4 * n + i;
                            const float r = sigmoidf_(acc[ai][0][m][n][i] + bA[e]), ig = sigmoidf_(acc[ai][1][m][n][i] + bX[e]);
                            const float av = __expf(sp8[e] * r), o1 = 1.0f - av;
                            om[e] = o1; uu[e] = __builtin_amdgcn_sqrtf(fmaxf(o1 * (1.0f + av), 0.f)) * ig * xc[e]; }
                    v4u w; w.x = pk2(om[0], om[1]); w.y = pk2(om[2], om[3]); w.z = pk2(om[4], om[5]); w.w = pk2(om[6], om[7]);
                    st16_wt(O0 + off, w);
                    w.x = pk2(uu[0], uu[1]); w.y = pk2(uu[2], uu[3]); w.z = pk2(uu[4], uu[5]); w.w = pk2(uu[6], uu[7]);
                    st16_wt(O1 + off, w);
                }
        } else if (mode == 3) {
            bf16* base = O0 + (size_t)row0 * D + u.pn * 256 + wc * 32 + 8 * fq;
#pragma unroll
            for (int ai = 0; ai < 2; ++ai)
#pragma unroll
                for (int m = 0; m < 4; ++m) {
                    bf16* rowp = base + (size_t)(ai * 128 + m * 16) * D; float ss = 0.f;
#pragma unroll
                    for (int bj = 0; bj < 2; ++bj) { const pg8::f32x4 v0 = acc[ai][bj][m][0], v1 = acc[ai][bj][m][1];
                        ss += (v0[0] * v0[0] + v0[1] * v0[1]) + (v0[2] * v0[2] + v0[3] * v0[3]) + (v1[0] * v1[0] + v1[1] * v1[1]) + (v1[2] * v1[2] + v1[3] * v1[3]);
                        v4u w; w.x = pk2(v0[0], v0[1]); w.y = pk2(v0[2], v0[3]); w.z = pk2(v1[0], v1[1]); w.w = pk2(v1[2], v1[3]);
                        st16_wt(rowp + bj * 128, w); }
                    ss += __shfl_xor(ss, 16); ss += __shfl_xor(ss, 32);
                    if (fq == 0) st4_wt(stats + (size_t)(row0 + ai * 128 + m * 16) * 16 + u.pn * 4 + wc, ss);
                }
        } else if (mode == 1 || (mode == 2 && u.pn >= 4)) {
            const int ldc = (mode == 1) ? DFF : D; const int q = (mode == 1) ? u.pn : (u.pn - 4);
            bf16* base = (mode == 1 ? O0 : O1) + (size_t)row0 * ldc + q * 128 + wc * 32 + 8 * fq;
#pragma unroll
            for (int ai = 0; ai < 2; ++ai)
#pragma unroll
                for (int m = 0; m < 4; ++m) {
                    pg8::f32x4 g0 = acc[ai][0][m][0], g1 = acc[ai][0][m][1]; const pg8::f32x4 u0 = acc[ai][1][m][0], u1 = acc[ai][1][m][1];
                    if (mode == 1) {
#pragma unroll
                        for (int i = 0; i < 4; ++i) { g0[i] = silu_(g0[i]); g1[i] = silu_(g1[i]); } }
                    g0 = g0 * u0; g1 = g1 * u1;
                    v4u w; w.x = pk2(g0[0], g0[1]); w.y = pk2(g0[2], g0[3]); w.z = pk2(g1[0], g1[1]); w.w = pk2(g1[2], g1[3]);
                    st16_wt(base + (size_t)(ai * 128 + m * 16) * ldc, w);
                }
        } else {
            const bool act = (mode == 0 && u.pn < 4);
            bf16* base = (u.pn < 4 ? O0 : O1) + (size_t)row0 * D + (u.pn & 3) * 256 + wc * 32 + 8 * fq;
#pragma unroll
            for (int ai = 0; ai < 2; ++ai)
#pragma unroll
                for (int m = 0; m < 4; ++m) {
                    bf16* rowp = base + (size_t)(ai * 128 + m * 16) * D;
#pragma unroll
                    for (int bj = 0; bj < 2; ++bj) { pg8::f32x4 v0 = acc[ai][bj][m][0], v1 = acc[ai][bj][m][1];
                        if (act) {
#pragma unroll
                            for (int i = 0; i < 4; ++i) { v0[i] = gelu_tanh(v0[i]); v1[i] = gelu_tanh(v1[i]); } }
                        v4u w; w.x = pk2(v0[0], v0[1]); w.y = pk2(v0[2], v0[3]); w.z = pk2(v1[0], v1[1]); w.w = pk2(v1[2], v1[3]);
                        st16_wt(rowp + bj * 128, w); }
                }
        }
    }
};

__device__ __forceinline__ float* xrow(const Args& a, int r) {
    if (r < NPR) { const int b = r / TP, t = r - b * TP;
        if (t < 16) return (float*)(a.ws + WS_XMETA) + (size_t)(b * 16 + t) * D;
        return a.out + O_YP + (size_t)(b * 2048 + (t - 16)) * D; }
    return a.out + O_YS + (size_t)(r - NPR) * D;
}
__device__ __forceinline__ const float* xsrc(const Args& a, int r) {
    if (r < NPR) { const int b = r / TP, t = r - b * TP;
        if (t < 16) return a.in[5] + (size_t)t * D;
        return a.in[0] + (size_t)(b * 2048 + (t - 16)) * D; }
    return a.in[1] + (size_t)(r - NPR) * D;
}

__device__ __forceinline__ int rowmap(int kind, int n) {
    if (kind == 0) return n;
    if (kind == 1) return 256 * (n >> 7) + (n & 127);
    if (kind == 2) return 256 * (n >> 7) + 128 + (n & 127);
    if (n < 1024) return n;
    if (n < 2048) { const int c = n - 1024; return 1024 + 256 * (c >> 7) + (c & 127); }
    { const int c = n - 2048; return 1024 + 256 * (c >> 7) + 128 + (c & 127); }
}
__device__ __forceinline__ void transpose_item(const float* W, int K, int N, bf16* WT, int kind, LAS float* scr, int item, int lane) {
    const int nblk = N / 32, kb = item / nblk, nb = item - kb * nblk, k0 = 64 * kb, n0 = 32 * nb;
    const GAS float* Wg = (const GAS float*)W;
#pragma unroll 8
    for (int i = 0; i < 32; ++i) { const int kk = 2 * i + (lane >> 5); scr[kk * 33 + (lane & 31)] = Wg[(size_t)(k0 + kk) * N + n0 + (lane & 31)]; }
    LDS_WAIT(); asm volatile("" ::: "memory");
    const int c = lane & 7; const int rb = rowmap(kind, n0);
#pragma unroll
    for (int j = 0; j < 4; ++j) { const int n = (lane >> 3) + 8 * j; const LAS float* s = scr + (8 * c) * 33 + n;
        v4u o; o.x = pk2(s[0 * 33], s[1 * 33]); o.y = pk2(s[2 * 33], s[3 * 33]); o.z = pk2(s[4 * 33], s[5 * 33]); o.w = pk2(s[6 * 33], s[7 * 33]);
        *(GAS v4u*)(WT + (size_t)(rb + n) * K + k0 + 8 * c) = o; }
    LDS_WAIT(); asm volatile("" ::: "memory");
}
constexpr int I_IN0 = 16 * 64, I_G = 4 * 8, I_O = 16 * 32, I_SC = 16 * 96, I_GU = 16 * 88, I_DN = 44 * 32;
constexpr int NITEMS = I_IN0 + 8 * I_G + 2 * I_O + I_SC + 4 * I_GU + 2 * I_DN, NITEMS_A = I_IN0 + 8 * I_G;
__device__ __forceinline__ void p0_item(const Args& a, LAS float* scr, int it, int lane) {
    unsigned char* ws = a.ws;
    do {
        int r = it;
        if (r < I_IN0) { transpose_item(a.in[10], 1024, 2048, (bf16*)(ws + WS_WIN0), 0, scr, r, lane); continue; } r -= I_IN0;
        if (r < 8 * I_G) { const int m = r / I_G, h = m & 3, gx = m >> 2;
            transpose_item(a.in[gx ? 15 : 13] + (size_t)h * 65536, 256, 256, (bf16*)(ws + WS_WG) + (size_t)h * 131072, gx ? 2 : 1, scr, r - m * I_G, lane); continue; } r -= 8 * I_G;
        if (r < I_O) { transpose_item(a.in[18], 1024, 1024, (bf16*)(ws + WS_WOUT0), 0, scr, r, lane); continue; } r -= I_O;
        if (r < I_SC) { transpose_item(a.in[19], 1024, 3072, (bf16*)(ws + WS_WSCIN), 3, scr, r, lane); continue; } r -= I_SC;
        if (r < I_O) { transpose_item(a.in[21], 1024, 1024, (bf16*)(ws + WS_WSCOUT), 0, scr, r, lane); continue; } r -= I_O;
        if (r < 4 * I_GU) { const int m = r / I_GU, l = m & 1, up = m >> 1;
            transpose_item(a.in[up ? 23 : 22] + (size_t)l * 1024 * DFF, 1024, DFF, (bf16*)(ws + WS_WGU) + (size_t)l * 5632 * 1024, up ? 2 : 1, scr, r - m * I_GU, lane); continue; } r -= 4 * I_GU;
        { const int l = r / I_DN; transpose_item(a.in[24] + (size_t)l * DFF * 1024, DFF, 1024, (bf16*)(ws + WS_WD) + (size_t)l * 1024 * DFF, 0, scr, r - l * I_DN, lane); }
    } while (0);
}
__device__ __forceinline__ void p0_phase(const Args& a, LAS unsigned char* lds, int wave, int lane) {
    { int t_ = lane_id(); asm volatile("" : "+v"(t_)); lane = t_; }
    LAS float* scr = (LAS float*)(lds + wave * 16384);
    const int gw = blockIdx.x * 8 + wave, NGW = gridDim.x * 8;
    unsigned char* ws = a.ws;
    for (int it = gw; it < NITEMS_A; it += NGW) p0_item(a, scr, it, lane);
    const GAS f32x4* wq = (const GAS f32x4*)a.in[6] + lane;
    f32x4 wpre[4];
#pragma unroll
    for (int j = 0; j < 4; ++j) wpre[j] = wq[64 * j];
    bf16* HN = (bf16*)(ws + WS_HN);
    for (int r0 = gw; r0 < MR; r0 += 2 * NGW) {
        f32x4 v[2][4]; float ss[2] = {0.f, 0.f};
#pragma unroll
        for (int u = 0; u < 2; ++u) { const int r = (r0 + u * NGW < MR) ? r0 + u * NGW : r0; const GAS f32x4* xs = (const GAS f32x4*)xsrc(a, r) + lane;
#pragma unroll
            for (int j = 0; j < 4; ++j) v[u][j] = xs[64 * j]; }
#pragma unroll
        for (int u = 0; u < 2; ++u) {
#pragma unroll
            for (int j = 0; j < 4; ++j) ss[u] += (v[u][j].x * v[u][j].x + v[u][j].y * v[u][j].y) + (v[u][j].z * v[u][j].z + v[u][j].w * v[u][j].w);
            const float rs = rsqrtf(wave_sum(ss[u]) * (1.0f / D) + EPS);
            const int r = r0 + u * NGW;
            if (r < MR) { GAS v2u* o8 = (GAS v2u*)(HN + (size_t)r * D) + lane;
#pragma unroll
                for (int j = 0; j < 4; ++j) { const f32x4 h = v[u][j] * rs * wpre[j]; v2u o; o.x = pk2(h.x, h.y); o.y = pk2(h.z, h.w); o8[64 * j] = o; } }
        }
    }
}

constexpr int CW_CNT = 4096, CW_BANK = 8192, CW_Q = CW_CNT + 14 * CW_BANK, CTL_WORDS = CW_Q + 8 * 64;
__device__ __forceinline__ unsigned ld_rlx(unsigned* p) { return __hip_atomic_load(p, __ATOMIC_RELAXED, __HIP_MEMORY_SCOPE_AGENT); }
struct PubOrder : pg8::StaticOrder {
    unsigned* cnt;
    __device__ __forceinline__ void done(const pg8::Unit& u) const {
        asm volatile("s_waitcnt vmcnt(0)" ::: "memory");
        if (lane_id() == 0) __hip_atomic_fetch_add(cnt + 64 * u.pm, 1u, __ATOMIC_RELAXED, __HIP_MEMORY_SCOPE_AGENT);
    }
};
struct ExtraOrder : PubOrder {
    int ksl;
    __device__ __forceinline__ bool next(int i, pg8::Unit& u) const { const int L = i * G + c; if (L >= 12 * ksl) return false; u.pm = 64 + L / (4 * ksl); u.pn = L % (4 * ksl); return true; }
};
struct CountedOrder : pg8::StaticOrder {
    unsigned* gready; unsigned gneed;
    unsigned* ready; unsigned need, need66; int wv;
    unsigned* gcnt;
    unsigned* cnt;
    __device__ __forceinline__ void a_ready(const pg8::Unit& u) const {
        if (wv == 0) {
            const unsigned nd = (u.pm < 66) ? need : need66;
            unsigned sp = 0;
            while ((unsigned)__builtin_amdgcn_readfirstlane(__hip_atomic_load(ready + 64 * u.pm, __ATOMIC_RELAXED, __HIP_MEMORY_SCOPE_AGENT)) < nd) { __builtin_amdgcn_s_sleep(2); if (++sp > (1u << 18)) break; }
            if (gready) { while ((unsigned)__builtin_amdgcn_readfirstlane(__hip_atomic_load(gready, __ATOMIC_RELAXED, __HIP_MEMORY_SCOPE_AGENT)) < gneed) { __builtin_amdgcn_s_sleep(2); if (++sp > (1u << 18)) break; } }
            __builtin_amdgcn_fence(__ATOMIC_ACQUIRE, "agent");
            asm volatile("s_waitcnt vmcnt(0)" ::: "memory");
        }
        asm volatile("" ::: "memory"); __builtin_amdgcn_s_barrier(); asm volatile("" ::: "memory");
    }
    __device__ __forceinline__ void done(const pg8::Unit& u) const {
        if (cnt) { asm volatile("s_waitcnt vmcnt(0)" ::: "memory");
            if (lane_id() == 0) { __hip_atomic_fetch_add(cnt + 64 * u.pm, 1u, __ATOMIC_RELAXED, __HIP_MEMORY_SCOPE_AGENT); if (gcnt) __hip_atomic_fetch_add(gcnt, 1u, __ATOMIC_RELAXED, __HIP_MEMORY_SCOPE_AGENT); } }
    }
};
struct ExtraOrderC : CountedOrder {
    int ksl;
    __device__ __forceinline__ bool next(int i, pg8::Unit& u) const { const int L = i * G + c; if (L >= 12 * ksl) return false; u.pm = 64 + L / (4 * ksl); u.pn = L % (4 * ksl); return true; }
};
#define TAIL_BEGIN(BANK, NCHUNKS, NEED, PLO_EXPR, PHI_EXPR) \
    for (;;) { __syncthreads(); \
        if (wave == 0 && lane_id() == 0) { const unsigned c_ = __hip_atomic_fetch_add(ctl + CW_Q + 64 * (BANK), 1u, __ATOMIC_RELAXED, __HIP_MEMORY_SCOPE_AGENT); \
            if (c_ < (unsigned)(NCHUNKS)) { const int chunk = (int)c_; const int plo_ = (PLO_EXPR), phi_ = (PHI_EXPR); \
                for (int p_ = plo_; p_ <= phi_; ++p_) { unsigned sp_ = 0; while (ld_rlx(ctl + CW_CNT + (BANK) * CW_BANK + 64 * p_) < (unsigned)(NEED)) { __builtin_amdgcn_s_sleep(2); if (++sp_ > (1u << 18)) break; } } \
                __builtin_amdgcn_fence(__ATOMIC_ACQUIRE, "agent"); asm volatile("s_waitcnt vmcnt(0)" ::: "memory"); } \
            *bc = c_; } \
        __syncthreads(); \
        const unsigned cu_ = *bc; if (cu_ >= (unsigned)(NCHUNKS)) break; const int chunk = (int)cu_;
#define TAIL_END }
#define TAIL_BEGIN_PUB(BANK, PUBBANK, NCHUNKS, NEED, PLO_EXPR, PHI_EXPR) \
    int prevp_ = -1; \
    for (;;) { __syncthreads(); \
        if (wave == 0 && lane_id() == 0) { \
            if (prevp_ >= 0) { __hip_atomic_fetch_add(ctl + CW_CNT + (PUBBANK) * CW_BANK + 64 * prevp_, 1u, __ATOMIC_RELAXED, __HIP_MEMORY_SCOPE_AGENT); \
                               __hip_atomic_fetch_add(ctl + CW_CNT + (PUBBANK) * CW_BANK + 64 * 100, 1u, __ATOMIC_RELAXED, __HIP_MEMORY_SCOPE_AGENT); } \
            const unsigned c_ = __hip_atomic_fetch_add(ctl + CW_Q + 64 * (BANK), 1u, __ATOMIC_RELAXED, __HIP_MEMORY_SCOPE_AGENT); \
            if (c_ < (unsigned)(NCHUNKS)) { const int chunk = (int)c_; const int plo_ = (PLO_EXPR), phi_ = (PHI_EXPR); \
                for (int p_ = plo_; p_ <= phi_; ++p_) { unsigned sp_ = 0; while (ld_rlx(ctl + CW_CNT + (BANK) * CW_BANK + 64 * p_) < (unsigned)(NEED)) { __builtin_amdgcn_s_sleep(2); if (++sp_ > (1u << 18)) break; } } \
                __builtin_amdgcn_fence(__ATOMIC_ACQUIRE, "agent"); asm volatile("s_waitcnt vmcnt(0)" ::: "memory"); } \
            *bc = c_; } \
        __syncthreads(); \
        const unsigned cu_ = *bc; if (cu_ >= (unsigned)(NCHUNKS)) break; const int chunk = (int)cu_; prevp_ = (PHI_EXPR);

__device__ __forceinline__ void p0b_tail(const Args& a, LAS unsigned char* lds, int wave, int lane, unsigned* ctl, volatile LAS unsigned* bc) {
    { int t_ = lane_id(); asm volatile("" : "+v"(t_)); lane = t_; }
    LAS float* scr = (LAS float*)(lds + wave * 16384);
    constexpr int NCH = (NITEMS - NITEMS_A + 7) / 8;
    for (;;) { __syncthreads();
        if (wave == 0 && lane_id() == 0) *bc = __hip_atomic_fetch_add(ctl + CW_Q + 64 * 7, 1u, __ATOMIC_RELAXED, __HIP_MEMORY_SCOPE_AGENT);
        __syncthreads();
        const unsigned c = *bc; if (c >= (unsigned)NCH) break;
        const int it = NITEMS_A + 8 * (int)c + wave;
        if (it < NITEMS) p0_item(a, scr, it, lane);
    }
}
template <bool FIRST, int XS, int PUB>
__device__ __forceinline__ void norm_res_tail(const Args& a, const float* wpost_, const float* wpre_, int wave, int lane, unsigned* ctl, int bank, volatile LAS unsigned* bc) {
    { int t_ = lane_id(); asm volatile("" : "+v"(t_)); lane = t_; }
    const GAS f32x4* wp4 = (const GAS f32x4*)wpost_ + lane;
    f32x4 wpost[4], wpre[4];
#pragma unroll
    for (int j = 0; j < 4; ++j) { wpost[j] = wp4[64 * j]; wpre[j] = wpre_ ? ((const GAS f32x4*)wpre_ + lane)[64 * j] : (f32x4){0.f, 0.f, 0.f, 0.f}; }
    const GAS float* stats = (const GAS float*)(a.ws + WS_STATS);
    const bf16* Y = (const bf16*)(a.ws + WS_Y); const bf16* PX = (const bf16*)(a.ws + WS_Y2); bf16* HN = (bf16*)(a.ws + WS_HN);
    int prev_panel = -1;
    for (;;) { __syncthreads();
        if (wave == 0 && lane_id() == 0) {
            if (PUB >= 0 && prev_panel >= 0) __hip_atomic_fetch_add(ctl + CW_CNT + (PUB >= 0 ? PUB : 0) * CW_BANK + 64 * prev_panel, 1u, __ATOMIC_RELAXED, __HIP_MEMORY_SCOPE_AGENT);
            const unsigned c_ = __hip_atomic_fetch_add(ctl + CW_Q + 64 * bank, 1u, __ATOMIC_RELAXED, __HIP_MEMORY_SCOPE_AGENT);
            if (c_ < (unsigned)(MR / 32)) { const int p_ = (int)c_ >> 3; unsigned sp_ = 0;
                while (ld_rlx(ctl + CW_CNT + bank * CW_BANK + 64 * p_) < (unsigned)(p_ < 64 ? 32 : 32 * XS)) { __builtin_amdgcn_s_sleep(2); if (++sp_ > (1u << 18)) break; }
                __builtin_amdgcn_fence(__ATOMIC_ACQUIRE, "agent"); asm volatile("s_waitcnt vmcnt(0)" ::: "memory"); }
            *bc = c_; }
        __syncthreads();
        const unsigned cu_ = *bc; if (cu_ >= (unsigned)(MR / 32)) break; const int chunk = (int)cu_; prev_panel = chunk >> 3;
    if (chunk * 32 < MAINR) {
#pragma unroll
    for (int k = 0; k < 4; ++k) {
        const int r = chunk * 32 + wave * 4 + k;
        GAS f32x4* xp = (GAS f32x4*)xrow(a, r) + lane; const GAS f32x4* xs = (const GAS f32x4*)xsrc(a, r) + lane;
        GAS v2u* xb = (GAS v2u*)((GAS bf16*)xrow(a, r) + D) + lane;
        const GAS v2u* yp = (const GAS v2u*)(Y + (size_t)r * D) + lane;
        float s = (!false && lane < 16) ? stats[(size_t)r * 16 + lane] : 0.f;
        f32x4 v[4], yf[4]; v2u yy[4], y2[4];
#pragma unroll
        for (int j = 0; j < 4; ++j) { if (FIRST) v[j] = xs[64 * j]; else { const v2u q = xb[64 * j]; v[j] = (f32x4){bflo(q.x), bfhi(q.x), bflo(q.y), bfhi(q.y)}; } yy[j] = false ? (v2u){0u, 0u} : yp[64 * j]; }
#pragma unroll
        for (int j = 0; j < 4; ++j) { f32x4 y; y.x = bflo(yy[j].x); y.y = bfhi(yy[j].x); y.z = bflo(yy[j].y); y.w = bfhi(yy[j].y); yf[j] = y; }
        if (false) {
            v2u pq[XS][4];
#pragma unroll
            for (int sl = 0; sl < XS; ++sl) { const GAS v2u* pp = (const GAS v2u*)(PX + ((size_t)sl * XROWS + (size_t)(r - MAINR)) * D) + lane;
#pragma unroll
                for (int j = 0; j < 4; ++j) pq[sl][j] = pp[64 * j]; }
#pragma unroll
            for (int sl = 0; sl < XS; ++sl)
#pragma unroll
                for (int j = 0; j < 4; ++j) { yf[j].x += bflo(pq[sl][j].x); yf[j].y += bfhi(pq[sl][j].x); yf[j].z += bflo(pq[sl][j].y); yf[j].w += bfhi(pq[sl][j].y); }
#pragma unroll
            for (int j = 0; j < 4; ++j) s += (yf[j].x * yf[j].x + yf[j].y * yf[j].y) + (yf[j].z * yf[j].z + yf[j].w * yf[j].w);
        }
        const float rs = rsqrtf(wave_sum(s) * (1.0f / D) + EPS);
        float ss = 0.f;
#pragma unroll
        for (int j = 0; j < 4; ++j) { const f32x4 y = yf[j];
            v[j] = v[j] + y * rs * wpost[j]; if (wpre_) { v2u q; q.x = pk2(v[j].x, v[j].y); q.y = pk2(v[j].z, v[j].w); if (PUB >= 0) st8_wt(xb + 64 * j, q); else xb[64 * j] = q; } else xp[64 * j] = v[j];
            ss += (v[j].x * v[j].x + v[j].y * v[j].y) + (v[j].z * v[j].z + v[j].w * v[j].w); }
        if (wpre_) {
            const float rs1 = rsqrtf(wave_sum(ss) * (1.0f / D) + EPS);
            GAS v2u* o8 = (GAS v2u*)(HN + (size_t)r * D) + lane;
#pragma unroll
            for (int j = 0; j < 4; ++j) { const f32x4 h = v[j] * rs1 * wpre[j]; v2u o; o.x = pk2(h.x, h.y); o.y = pk2(h.z, h.w); if (PUB >= 0) st8_wt(o8 + 64 * j, o); else o8[64 * j] = o; }
        }
    }
    } else {
#pragma unroll 2
    for (int k = 0; k < 4; ++k) {
        const int r = chunk * 32 + wave * 4 + k;
        GAS f32x4* xp = (GAS f32x4*)xrow(a, r) + lane; const GAS f32x4* xs = (const GAS f32x4*)xsrc(a, r) + lane;
        GAS v2u* xb = (GAS v2u*)((GAS bf16*)xrow(a, r) + D) + lane;
        const GAS v2u* yp = (const GAS v2u*)(Y + (size_t)r * D) + lane;
        float s = (!true && lane < 16) ? stats[(size_t)r * 16 + lane] : 0.f;
        f32x4 v[4], yf[4]; v2u yy[4], y2[4];
#pragma unroll
        for (int j = 0; j < 4; ++j) { if (FIRST) v[j] = xs[64 * j]; else { const v2u q = xb[64 * j]; v[j] = (f32x4){bflo(q.x), bfhi(q.x), bflo(q.y), bfhi(q.y)}; } yy[j] = true ? (v2u){0u, 0u} : yp[64 * j]; }
#pragma unroll
        for (int j = 0; j < 4; ++j) { f32x4 y; y.x = bflo(yy[j].x); y.y = bfhi(yy[j].x); y.z = bflo(yy[j].y); y.w = bfhi(yy[j].y); yf[j] = y; }
        if (true) {
            v2u pq[XS][4];
#pragma unroll
            for (int sl = 0; sl < XS; ++sl) { const GAS v2u* pp = (const GAS v2u*)(PX + ((size_t)sl * XROWS + (size_t)(r - MAINR)) * D) + lane;
#pragma unroll
                for (int j = 0; j < 4; ++j) pq[sl][j] = pp[64 * j]; }
#pragma unroll
            for (int sl = 0; sl < XS; ++sl)
#pragma unroll
                for (int j = 0; j < 4; ++j) { yf[j].x += bflo(pq[sl][j].x); yf[j].y += bfhi(pq[sl][j].x); yf[j].z += bflo(pq[sl][j].y); yf[j].w += bfhi(pq[sl][j].y); }
#pragma unroll
            for (int j = 0; j < 4; ++j) s += (yf[j].x * yf[j].x + yf[j].y * yf[j].y) + (yf[j].z * yf[j].z + yf[j].w * yf[j].w);
        }
        const float rs = rsqrtf(wave_sum(s) * (1.0f / D) + EPS);
        float ss = 0.f;
#pragma unroll
        for (int j = 0; j < 4; ++j) { const f32x4 y = yf[j];
            v[j] = v[j] + y * rs * wpost[j]; if (wpre_) { v2u q; q.x = pk2(v[j].x, v[j].y); q.y = pk2(v[j].z, v[j].w); if (PUB >= 0) st8_wt(xb + 64 * j, q); else xb[64 * j] = q; } else xp[64 * j] = v[j];
            ss += (v[j].x * v[j].x + v[j].y * v[j].y) + (v[j].z * v[j].z + v[j].w * v[j].w); }
        if (wpre_) {
            const float rs1 = rsqrtf(wave_sum(ss) * (1.0f / D) + EPS);
            GAS v2u* o8 = (GAS v2u*)(HN + (size_t)r * D) + lane;
#pragma unroll
            for (int j = 0; j < 4; ++j) { const f32x4 h = v[j] * rs1 * wpre[j]; v2u o; o.x = pk2(h.x, h.y); o.y = pk2(h.z, h.w); if (PUB >= 0) st8_wt(o8 + 64 * j, o); else o8[64 * j] = o; }
        }
    }
    }
    if (PUB >= 0) asm volatile("s_waitcnt vmcnt(0)" ::: "memory");
    TAIL_END
}

__device__ __forceinline__ void rgconv_tail(const Args& a, unsigned* ctl, volatile LAS unsigned* bc, const int wave) {
    int tidx = wave * 64 + lane_id(); asm volatile("" : "+v"(tidx));
    const bf16* XR = (const bf16*)(a.ws + WS_R1B); bf16* XC = (bf16*)(a.ws + WS_HN);
    const GAS float* cw = (const GAS float*)a.in[11]; const GAS float* cb = (const GAS float*)a.in[12]; const GAS float* st = (const GAS float*)a.in[2];
    const int ch0 = 8 * (tidx & 127);
    float w[4][8], bb[8];
#pragma unroll
    for (int k = 0; k < 4; ++k) { const f32x4 w0 = *(const GAS f32x4*)(cw + k * D + ch0), w1 = *(const GAS f32x4*)(cw + k * D + ch0 + 4);
        w[k][0] = w0.x; w[k][1] = w0.y; w[k][2] = w0.z; w[k][3] = w0.w; w[k][4] = w1.x; w[k][5] = w1.y; w[k][6] = w1.z; w[k][7] = w1.w; }
    { const f32x4 b0 = *(const GAS f32x4*)(cb + ch0), b1 = *(const GAS f32x4*)(cb + ch0 + 4);
        bb[0] = b0.x; bb[1] = b0.y; bb[2] = b0.z; bb[3] = b0.w; bb[4] = b1.x; bb[5] = b1.y; bb[6] = b1.z; bb[7] = b1.w; }
    TAIL_BEGIN(0, MR / 32, 64, (chunk > 0 ? (32 * chunk - 3) >> 8 : 0), (32 * chunk) >> 8)
    if (32 * chunk < NPR) {
        const int R0 = 32 * chunk + 8 * (tidx >> 7), bq = R0 / TP, t0 = R0 - bq * TP;
        v4u win[11];
#pragma unroll
        for (int wi = 0; wi < 11; ++wi) win[wi] = (t0 - 3 + wi >= 0) ? *(const GAS v4u*)(XR + (size_t)(R0 - 3 + wi) * D + ch0) : (v4u){0u, 0u, 0u, 0u};
#pragma unroll
        for (int i = 0; i < 8; ++i) {
            float c8[8];
#pragma unroll
            for (int e = 0; e < 8; ++e) c8[e] = bb[e];
#pragma unroll
            for (int k = 0; k < 4; ++k) { const v4u q = win[i + k]; const float x[8] = {bflo(q.x), bfhi(q.x), bflo(q.y), bfhi(q.y), bflo(q.z), bfhi(q.z), bflo(q.w), bfhi(q.w)};
#pragma unroll
                for (int e = 0; e < 8; ++e) c8[e] = fmaf(w[k][e], x[e], c8[e]); }
            if (t0 + i >= TP - 3) { const v4u q = win[i + 3]; const float x[8] = {bflo(q.x), bfhi(q.x), bflo(q.y), bfhi(q.y), bflo(q.z), bfhi(q.z), bflo(q.w), bfhi(q.w)};
                GAS float* dst = (GAS float*)a.out + O_RCP + (size_t)(bq * 3 + (t0 + i - (TP - 3))) * D + ch0;
                *(GAS f32x4*)dst = (f32x4){x[0], x[1], x[2], x[3]}; *(GAS f32x4*)(dst + 4) = (f32x4){x[4], x[5], x[6], x[7]}; }
            v4u o; o.x = pk2(c8[0], c8[1]); o.y = pk2(c8[2], c8[3]); o.z = pk2(c8[4], c8[5]); o.w = pk2(c8[6], c8[7]);
            *(GAS v4u*)(XC + (size_t)(R0 + i) * D + ch0) = o;
        }
    } else
#pragma unroll 4
    for (int i_ = 0; i_ < 8; ++i_) {
        const int R = 32 * chunk + (tidx >> 7) + 4 * i_;
        int t, T, bq; const bool is_sample = (R >= NPR);
        if (!is_sample) { bq = R / TP; t = R - bq * TP; T = TP; } else { bq = (R - NPR) >> 2; t = (R - NPR) & 3; T = 4; }
        float c8[8];
#pragma unroll
        for (int e = 0; e < 8; ++e) c8[e] = bb[e];
#pragma unroll
        for (int k = 0; k < 4; ++k) {
            const int tt = t - 3 + k; float x[8];
            if (tt >= 0) { const v4u q = *(const GAS v4u*)(XR + (size_t)(R - 3 + k) * D + ch0);
                x[0] = bflo(q.x); x[1] = bfhi(q.x); x[2] = bflo(q.y); x[3] = bfhi(q.y); x[4] = bflo(q.z); x[5] = bfhi(q.z); x[6] = bflo(q.w); x[7] = bfhi(q.w); }
            else if (is_sample) { const GAS float* sp = st + (size_t)(bq * 3 + (3 + tt)) * D + ch0; const f32x4 q0 = *(const GAS f32x4*)sp, q1 = *(const GAS f32x4*)(sp + 4);
                x[0] = q0.x; x[1] = q0.y; x[2] = q0.z; x[3] = q0.w; x[4] = q1.x; x[5] = q1.y; x[6] = q1.z; x[7] = q1.w; }
            else {
#pragma unroll
                for (int e = 0; e < 8; ++e) x[e] = 0.f; }
#pragma unroll
            for (int e = 0; e < 8; ++e) c8[e] = fmaf(w[k][e], x[e], c8[e]);
            if (k == 3 && t >= T - 3) {
                GAS float* dst = (GAS float*)a.out + (is_sample ? O_RCS : O_RCP) + (size_t)(bq * 3 + (t - (T - 3))) * D + ch0;
                *(GAS f32x4*)dst = (f32x4){x[0], x[1], x[2], x[3]}; *(GAS f32x4*)(dst + 4) = (f32x4){x[4], x[5], x[6], x[7]};
            }
        }
        v4u o; o.x = pk2(c8[0], c8[1]); o.y = pk2(c8[2], c8[3]); o.z = pk2(c8[4], c8[5]); o.w = pk2(c8[6], c8[7]);
        *(GAS v4u*)(XC + (size_t)R * D + ch0) = o;
    }
    TAIL_END
}

__device__ __forceinline__ bool seq_start(int R) { return R < NPR ? (R % TP == 0) : (((R - NPR) & 3) == 0); }
__device__ __forceinline__ bool seq_end(int R) { return R < NPR ? (R % TP == TP - 1) : (((R - NPR) & 3) == 3); }
template <int PASS>
__device__ __forceinline__ void lru_scan_item(const Args& a, LAS unsigned char* lds, const int j, const int q, const int wave, unsigned* ctl = nullptr) {
    int tid_ = wave * 64 + lane_id(); asm volatile("" : "+v"(tid_));
    const int tid = tid_, sub = tid >> 5, oct = tid & 31;
    const bf16* OMA = (const bf16*)(a.ws + WS_Y); const bf16* U = (const bf16*)(a.ws + WS_R1B); const bf16* GG = (const bf16*)(a.ws + WS_R1); bf16* A2 = (bf16*)(a.ws + WS_HN);
    GAS float* AGG = (GAS float*)(a.ws + WS_AGG); const GAS float* sth = (const GAS float*)a.in[3];
    LAS float* sagg = (LAS float*)lds;
    {
        const int ch0 = 256 * q + 8 * oct, Rb = 64 * j + 4 * sub;
        v4u qa[4], qu[4], gq[4];
#pragma unroll
        for (int rr = 0; rr < 4; ++rr) { qa[rr] = *(const GAS v4u*)(OMA + (size_t)(Rb + rr) * D + ch0); qu[rr] = *(const GAS v4u*)(U + (size_t)(Rb + rr) * D + ch0);
            if (PASS == 2) gq[rr] = *(const GAS v4u*)(GG + (size_t)(Rb + rr) * D + ch0); }
        float av[4][8], uv[4][8], h0[4][8];
#pragma unroll
        for (int rr = 0; rr < 4; ++rr) {
            av[rr][0] = 1.f - bflo(qa[rr].x); av[rr][1] = 1.f - bfhi(qa[rr].x); av[rr][2] = 1.f - bflo(qa[rr].y); av[rr][3] = 1.f - bfhi(qa[rr].y);
            av[rr][4] = 1.f - bflo(qa[rr].z); av[rr][5] = 1.f - bfhi(qa[rr].z); av[rr][6] = 1.f - bflo(qa[rr].w); av[rr][7] = 1.f - bfhi(qa[rr].w);
            uv[rr][0] = bflo(qu[rr].x); uv[rr][1] = bfhi(qu[rr].x); uv[rr][2] = bflo(qu[rr].y); uv[rr][3] = bfhi(qu[rr].y);
            uv[rr][4] = bflo(qu[rr].z); uv[rr][5] = bfhi(qu[rr].z); uv[rr][6] = bflo(qu[rr].w); uv[rr][7] = bfhi(qu[rr].w);
            const int R = Rb + rr;
            if (R >= NPR && ((R - NPR) & 3) == 0) { const GAS float* hp = sth + (size_t)((R - NPR) >> 2) * D + ch0; const f32x4 p0 = *(const GAS f32x4*)hp, p1 = *(const GAS f32x4*)(hp + 4);
                h0[rr][0] = p0.x; h0[rr][1] = p0.y; h0[rr][2] = p0.z; h0[rr][3] = p0.w; h0[rr][4] = p1.x; h0[rr][5] = p1.y; h0[rr][6] = p1.z; h0[rr][7] = p1.w; }
            else {
#pragma unroll
                for (int e = 0; e < 8; ++e) h0[rr][e] = 0.f; }
        }
        const bool lookback = (PASS == 2) && (64 * j < NPR);
        if (lookback) {
            const int jt0 = (((64 * j) / TP) * TP) >> 6, n = j - jt0;
            float SA[8], SH[8];
#pragma unroll
            for (int e = 0; e < 8; ++e) { SA[e] = 1.f; SH[e] = 0.f; }
            f32x4 ev[3][4];
#pragma unroll
            for (int k = 0; k < 3; ++k) { const int idx = 3 * sub + k;
                if (idx < n) { const GAS f32x4* src = (const GAS f32x4*)(AGG + ((size_t)(jt0 + idx) * D + ch0) * 2);
#pragma unroll
                    for (int e = 0; e < 4; ++e) ev[k][e] = src[e]; }
                else {
#pragma unroll
                    for (int e = 0; e < 4; ++e) ev[k][e] = (f32x4){1.f, 0.f, 1.f, 0.f}; } }
#pragma unroll
            for (int k = 0; k < 3; ++k) if (3 * sub + k < n) {
#pragma unroll
                for (int e = 0; e < 4; ++e) { const f32x4 v = ev[k][e]; SH[2 * e] = fmaf(v.x, SH[2 * e], v.y); SA[2 * e] *= v.x; SH[2 * e + 1] = fmaf(v.z, SH[2 * e + 1], v.w); SA[2 * e + 1] *= v.z; } }
            LAS f32x4* dst = (LAS f32x4*)(sagg + 8192 + (size_t)(sub * 256 + 8 * oct) * 2);
#pragma unroll
            for (int e = 0; e < 4; ++e) dst[e] = (f32x4){SA[2 * e], SH[2 * e], SA[2 * e + 1], SH[2 * e + 1]};
        }
        float A8[8], H8[8];
#pragma unroll
        for (int e = 0; e < 8; ++e) { A8[e] = 1.f; H8[e] = 0.f; }
#pragma unroll
        for (int rr = 0; rr < 4; ++rr) { const bool st = seq_start(Rb + rr);
#pragma unroll
            for (int e = 0; e < 8; ++e) { const float hp = st ? h0[rr][e] : H8[e]; H8[e] = fmaf(av[rr][e], hp, uv[rr][e]); A8[e] = st ? 0.f : A8[e] * av[rr][e]; } }
        { LAS f32x4* dst = (LAS f32x4*)(sagg + (size_t)(sub * 256 + 8 * oct) * 2);
#pragma unroll
            for (int e = 0; e < 4; ++e) dst[e] = (f32x4){A8[2 * e], H8[2 * e], A8[2 * e + 1], H8[2 * e + 1]}; }
        __syncthreads();
        if (PASS == 1) {
            if (tid < 32) {
                float A[8], H[8];
#pragma unroll
                for (int e = 0; e < 8; ++e) { A[e] = 1.f; H[e] = 0.f; }
#pragma unroll 4
                for (int s = 0; s < 16; ++s) { const LAS f32x4* src = (const LAS f32x4*)(sagg + (size_t)(s * 256 + 8 * oct) * 2);
#pragma unroll
                    for (int e = 0; e < 4; ++e) { const f32x4 v = src[e]; H[2 * e] = fmaf(v.x, H[2 * e], v.y); A[2 * e] *= v.x; H[2 * e + 1] = fmaf(v.z, H[2 * e + 1], v.w); A[2 * e + 1] *= v.z; } }
                GAS f32x4* dst = (GAS f32x4*)(AGG + ((size_t)j * D + ch0) * 2);
#pragma unroll
                for (int e = 0; e < 4; ++e) st16f_wt(dst + e, (f32x4){A[2 * e], H[2 * e], A[2 * e + 1], H[2 * e + 1]});
                asm volatile("s_waitcnt vmcnt(0)" ::: "memory");
            }
        } else {
            float C8[8];
#pragma unroll
            for (int e = 0; e < 8; ++e) C8[e] = 0.f;
            {
                LAS float* tcar = sagg + 16384;
                LAS float* pref = sagg + 16384 + 256;
                if (lookback && tid < 32) {
#pragma unroll 4
                    for (int sg = 0; sg < 16; ++sg) { const LAS f32x4* src = (const LAS f32x4*)(sagg + 8192 + (size_t)(sg * 256 + 8 * oct) * 2);
#pragma unroll
                        for (int e = 0; e < 4; ++e) { const f32x4 v = src[e]; C8[2 * e] = fmaf(v.x, C8[2 * e], v.y); C8[2 * e + 1] = fmaf(v.z, C8[2 * e + 1], v.w); } }
                    *(LAS f32x4*)(tcar + 8 * oct) = (f32x4){C8[0], C8[1], C8[2], C8[3]}; *(LAS f32x4*)(tcar + 8 * oct + 4) = (f32x4){C8[4], C8[5], C8[6], C8[7]};
                }
                if (tid >= 64 && tid < 96) {
                    float PA[8], PH[8];
#pragma unroll
                    for (int e = 0; e < 8; ++e) { PA[e] = 1.f; PH[e] = 0.f; }
#pragma unroll 4
                    for (int sg = 0; sg < 16; ++sg) {
                        LAS f32x4* dst = (LAS f32x4*)(pref + (size_t)(sg * 256 + 8 * oct) * 2);
                        const LAS f32x4* src = (const LAS f32x4*)(sagg + (size_t)(sg * 256 + 8 * oct) * 2);
#pragma unroll
                        for (int e = 0; e < 4; ++e) { dst[e] = (f32x4){PA[2 * e], PH[2 * e], PA[2 * e + 1], PH[2 * e + 1]};
                            const f32x4 v = src[e]; PH[2 * e] = fmaf(v.x, PH[2 * e], v.y); PA[2 * e] *= v.x; PH[2 * e + 1] = fmaf(v.z, PH[2 * e + 1], v.w); PA[2 * e + 1] *= v.z; } }
                }
                __syncthreads();
                if (lookback) { const f32x4 c0 = *(const LAS f32x4*)(tcar + 8 * oct), c1 = *(const LAS f32x4*)(tcar + 8 * oct + 4);
                    C8[0] = c0.x; C8[1] = c0.y; C8[2] = c0.z; C8[3] = c0.w; C8[4] = c1.x; C8[5] = c1.y; C8[6] = c1.z; C8[7] = c1.w; }
                else {
#pragma unroll
                    for (int e = 0; e < 8; ++e) C8[e] = 0.f; }
                { const LAS f32x4* src = (const LAS f32x4*)(pref + (size_t)(sub * 256 + 8 * oct) * 2);
#pragma unroll
                    for (int e = 0; e < 4; ++e) { const f32x4 v = src[e]; C8[2 * e] = fmaf(v.x, C8[2 * e], v.y); C8[2 * e + 1] = fmaf(v.z, C8[2 * e + 1], v.w); } }
            }
#pragma unroll
            for (int rr = 0; rr < 4; ++rr) { const int R = Rb + rr; const bool st = seq_start(R);
                const v4u g = gq[rr];
#pragma unroll
                for (int e = 0; e < 8; ++e) { const float hp = st ? h0[rr][e] : C8[e]; C8[e] = fmaf(av[rr][e], hp, uv[rr][e]); }
                v4u o; o.x = pk2(C8[0] * bflo(g.x), C8[1] * bfhi(g.x)); o.y = pk2(C8[2] * bflo(g.y), C8[3] * bfhi(g.y));
                o.z = pk2(C8[4] * bflo(g.z), C8[5] * bfhi(g.z)); o.w = pk2(C8[6] * bflo(g.w), C8[7] * bfhi(g.w));
                st16_wt(A2 + (size_t)R * D + ch0, o);
                if (seq_end(R)) { GAS float* dst = (GAS float*)a.out + (R < NPR ? O_RHP + (size_t)(R / TP) * D : O_RHS + (size_t)((R - NPR) >> 2) * D) + ch0;
                    *(GAS f32x4*)dst = (f32x4){C8[0], C8[1], C8[2], C8[3]}; *(GAS f32x4*)(dst + 4) = (f32x4){C8[4], C8[5], C8[6], C8[7]}; }
            }
            asm volatile("s_waitcnt vmcnt(0)" ::: "memory");
        }
        __syncthreads();
        if (PASS == 2 && wave == 0 && lane_id() == 0) {
            __hip_atomic_fetch_add(ctl + CW_CNT + 12 * CW_BANK + 64 * (j >> 2), 1u, __ATOMIC_RELAXED, __HIP_MEMORY_SCOPE_AGENT);
            __hip_atomic_fetch_add(ctl + CW_CNT + 12 * CW_BANK + 64 * 100, 1u, __ATOMIC_RELAXED, __HIP_MEMORY_SCOPE_AGENT); }
    }
}

__device__ __forceinline__ void lru_scan1_tail(const Args& a, LAS unsigned char* lds, unsigned* ctl, volatile LAS unsigned* bc, const int wave) {
    TAIL_BEGIN(1, 266 * 2, 64, chunk >> 3, chunk >> 3)
    lru_scan_item<1>(a, lds, chunk >> 1, 2 * (chunk & 1), wave); lru_scan_item<1>(a, lds, chunk >> 1, 2 * (chunk & 1) + 1, wave);
    if (wave == 0 && lane_id() == 0) __hip_atomic_fetch_add(ctl + CW_CNT + 13 * CW_BANK + 16 * (chunk >> 1), 1u, __ATOMIC_RELAXED, __HIP_MEMORY_SCOPE_AGENT);
    TAIL_END
}
__device__ __forceinline__ void lru_scan2_phase(const Args& a, LAS unsigned char* lds, const int wave, unsigned* ctl) {
#pragma unroll 1
    for (int it = blockIdx.x; it < 266 * 4; it += gridDim.x) {
        const int j = it >> 2;
        if (wave == 0) {
            const int jt0 = (64 * j < NPR) ? ((((64 * j) / TP) * TP) >> 6) : j, n = j - jt0, l = lane_id();
            unsigned* w = (l < n) ? ctl + CW_CNT + 13 * CW_BANK + 16 * (jt0 + l) : ctl + CW_CNT + 1 * CW_BANK + 64 * (j >> 2);
            const unsigned nd = (l < n) ? 2u : (l == n ? 64u : 0u);
            unsigned sp = 0;
            while (!__all(__hip_atomic_load(w, __ATOMIC_RELAXED, __HIP_MEMORY_SCOPE_AGENT) >= nd)) { __builtin_amdgcn_s_sleep(2); if (++sp > (1u << 18)) break; }
            __builtin_amdgcn_fence(__ATOMIC_ACQUIRE, "agent"); asm volatile("s_waitcnt vmcnt(0)" ::: "memory");
        }
        __syncthreads();
        lru_scan_item<2>(a, lds, j, it & 3, wave, ctl);
    }
}

__device__ __forceinline__ void sconv_tail(const Args& a, unsigned* ctl, volatile LAS unsigned* bc, const int wave) {
    int tidx = wave * 64 + lane_id(); asm volatile("" : "+v"(tidx));
    const bf16* BG = (const bf16*)(a.ws + WS_R1); const bf16* CV = (const bf16*)(a.ws + WS_R1B); bf16* A3 = (bf16*)(a.ws + WS_HN);
    const GAS float* cw = (const GAS float*)a.in[20]; const GAS float* st = (const GAS float*)a.in[4];
    const int ch0 = 8 * (tidx & 127);
    float w[3][8];
#pragma unroll
    for (int k = 0; k < 3; ++k) { const f32x4 w0 = *(const GAS f32x4*)(cw + k * D + ch0), w1 = *(const GAS f32x4*)(cw + k * D + ch0 + 4);
        w[k][0] = w0.x; w[k][1] = w0.y; w[k][2] = w0.z; w[k][3] = w0.w; w[k][4] = w1.x; w[k][5] = w1.y; w[k][6] = w1.z; w[k][7] = w1.w; }
    TAIL_BEGIN_PUB(4, 10, MR / 32, 96, (chunk > 0 ? (32 * chunk - 2) >> 8 : 0), (32 * chunk) >> 8)
    if (32 * chunk < NPR) {
        const int R0 = 32 * chunk + 8 * (tidx >> 7), bq = R0 / TP, t0 = R0 - bq * TP;
        v4u win[10], bgq[8];
#pragma unroll
        for (int wi = 0; wi < 10; ++wi) win[wi] = (t0 - 2 + wi >= 0) ? *(const GAS v4u*)(CV + (size_t)(R0 - 2 + wi) * D + ch0) : (v4u){0u, 0u, 0u, 0u};
#pragma unroll
        for (int i = 0; i < 8; ++i) bgq[i] = *(const GAS v4u*)(BG + (size_t)(R0 + i) * D + ch0);
#pragma unroll
        for (int i = 0; i < 8; ++i) {
            float c8[8];
#pragma unroll
            for (int e = 0; e < 8; ++e) c8[e] = 0.f;
#pragma unroll
            for (int k = 0; k < 3; ++k) { const v4u q = win[i + k]; const float x[8] = {bflo(q.x), bfhi(q.x), bflo(q.y), bfhi(q.y), bflo(q.z), bfhi(q.z), bflo(q.w), bfhi(q.w)};
#pragma unroll
                for (int e = 0; e < 8; ++e) c8[e] = fmaf(w[k][e], x[e], c8[e]); }
            if (t0 + i >= TP - 2) { const v4u q = win[i + 2]; const float x[8] = {bflo(q.x), bfhi(q.x), bflo(q.y), bfhi(q.y), bflo(q.z), bfhi(q.z), bflo(q.w), bfhi(q.w)};
                GAS float* dst = (GAS float*)a.out + O_SCP + (size_t)(bq * 2 + (t0 + i - (TP - 2))) * D + ch0;
                *(GAS f32x4*)dst = (f32x4){x[0], x[1], x[2], x[3]}; *(GAS f32x4*)(dst + 4) = (f32x4){x[4], x[5], x[6], x[7]}; }
            const v4u g = bgq[i];
            v4u o; o.x = pk2(bflo(g.x) * c8[0], bfhi(g.x) * c8[1]); o.y = pk2(bflo(g.y) * c8[2], bfhi(g.y) * c8[3]);
            o.z = pk2(bflo(g.z) * c8[4], bfhi(g.z) * c8[5]); o.w = pk2(bflo(g.w) * c8[6], bfhi(g.w) * c8[7]);
            st16_wt(A3 + (size_t)(R0 + i) * D + ch0, o);
        }
    } else
#pragma unroll 4
    for (int i_ = 0; i_ < 8; ++i_) {
        const int R = 32 * chunk + (tidx >> 7) + 4 * i_;
        int t, T, bq; const bool is_sample = (R >= NPR);
        if (!is_sample) { bq = R / TP; t = R - bq * TP; T = TP; } else { bq = (R - NPR) >> 2; t = (R - NPR) & 3; T = 4; }
        float c8[8];
#pragma unroll
        for (int e = 0; e < 8; ++e) c8[e] = 0.f;
#pragma unroll
        for (int k = 0; k < 3; ++k) {
            const int tt = t - 2 + k; float x[8];
            if (tt >= 0) { const v4u q = *(const GAS v4u*)(CV + (size_t)(R - 2 + k) * D + ch0);
                x[0] = bflo(q.x); x[1] = bfhi(q.x); x[2] = bflo(q.y); x[3] = bfhi(q.y); x[4] = bflo(q.z); x[5] = bfhi(q.z); x[6] = bflo(q.w); x[7] = bfhi(q.w); }
            else if (is_sample) { const GAS float* sp = st + (size_t)(bq * 2 + (2 + tt)) * D + ch0; const f32x4 q0 = *(const GAS f32x4*)sp, q1 = *(const GAS f32x4*)(sp + 4);
                x[0] = q0.x; x[1] = q0.y; x[2] = q0.z; x[3] = q0.w; x[4] = q1.x; x[5] = q1.y; x[6] = q1.z; x[7] = q1.w; }
            else {
#pragma unroll
                for (int e = 0; e < 8; ++e) x[e] = 0.f; }
#pragma unroll
            for (int e = 0; e < 8; ++e) c8[e] = fmaf(w[k][e], x[e], c8[e]);
            if (k == 2 && t >= T - 2) {
                GAS float* dst = (GAS float*)a.out + (is_sample ? O_SCS : O_SCP) + (size_t)(bq * 2 + (t - (T - 2))) * D + ch0;
                *(GAS f32x4*)dst = (f32x4){x[0], x[1], x[2], x[3]}; *(GAS f32x4*)(dst + 4) = (f32x4){x[4], x[5], x[6], x[7]};
            }
        }
        const v4u g = *(const GAS v4u*)(BG + (size_t)R * D + ch0);
        v4u o; o.x = pk2(bflo(g.x) * c8[0], bfhi(g.x) * c8[1]); o.y = pk2(bflo(g.y) * c8[2], bfhi(g.y) * c8[3]);
        o.z = pk2(bflo(g.z) * c8[4], bfhi(g.z) * c8[5]); o.w = pk2(bflo(g.w) * c8[6], bfhi(g.w) * c8[7]);
        st16_wt(A3 + (size_t)R * D + ch0, o);
    }
    asm volatile("s_waitcnt vmcnt(0)" ::: "memory");
    TAIL_END
}

#define XB_TMO      128
#define XB_XCNT(j)  (256  + 64 * (j))
#define XB_XSUB(j)  (1280 + 64 * (j))
#define XB_XGEN(j)  (2304 + 64 * (j))
#define XB_TOP      3328
#define XB_TOPGEN   3392
#define XCD_BAR_WORDS 3456
#define XB_SPIN_CAP (1u << 18)

__device__ __forceinline__ unsigned xb_ld(unsigned* p)              { return __hip_atomic_load(p, __ATOMIC_RELAXED, __HIP_MEMORY_SCOPE_AGENT); }
__device__ __forceinline__ unsigned xb_add(unsigned* p, unsigned v) { return __hip_atomic_fetch_add(p, v, __ATOMIC_RELAXED, __HIP_MEMORY_SCOPE_AGENT); }
__device__ __forceinline__ unsigned xb_xcc_id() { return (unsigned)__builtin_amdgcn_s_getreg((3 << 11) | 20) & 0xFu; }
#define XB_SPIN(cond, bar) do { unsigned _sp = 0; while (cond) { __builtin_amdgcn_s_sleep(1); \
    if ((++_sp & 255u) == 0u) { if (xb_ld(&(bar)[XB_TMO])) break; if (_sp > XB_SPIN_CAP) { atomicAdd(&(bar)[XB_TMO], 1u); break; } } } } while (0)

struct XcdBarrier {
    unsigned* bar; unsigned x;
    volatile LAS unsigned* st;
};

__device__ __forceinline__ XcdBarrier xcd_barrier_post(unsigned* bar, volatile LAS unsigned* st, const int wave) {
    XcdBarrier b; b.bar = bar; b.x = xb_xcc_id(); b.st = st;
    if (wave == 0 && lane_id() == 0) (void)xb_add(&bar[XB_XCNT(b.x)], 1u);
    return b;
}
__device__ __forceinline__ void xcd_barrier_complete(unsigned* bar, unsigned x, unsigned& nloc, unsigned& nx) {
    const unsigned G = gridDim.x * gridDim.y * gridDim.z;
    unsigned sum, cnt, mine, sp = 0u;
    for (;;) {
        sum = 0u; cnt = 0u; mine = 0u;
#pragma unroll
        for (unsigned j = 0; j < 16; ++j) { const unsigned c = xb_ld(&bar[XB_XCNT(j)]); sum += c; cnt += (c > 0u) ? 1u : 0u; mine = (j == x) ? c : mine; }
        if (sum == G) break;
        __builtin_amdgcn_s_sleep(1);
        if ((++sp & 255u) == 0u) { if (xb_ld(&bar[XB_TMO])) break; if (sp > XB_SPIN_CAP) { atomicAdd(&bar[XB_TMO], 1u); break; } }
    }
    nloc = mine > 0u ? mine : 1u; nx = cnt > 0u ? cnt : 1u;
}

__device__ __forceinline__ void xcd_barrier(const XcdBarrier& b, const int wave) {
    asm volatile("s_waitcnt vmcnt(0)" ::: "memory");
    __syncthreads();
    if (wave == 0 && lane_id() == 0) {
        unsigned* bar = b.bar;
        __builtin_amdgcn_s_waitcnt(0);
        unsigned nloc = b.st[0], nx = b.st[1];
        if (nloc == 0u) { xcd_barrier_complete(bar, b.x, nloc, nx); b.st[0] = nloc; b.st[1] = nx; }
        const unsigned old = xb_add(&bar[XB_XSUB(b.x)], 1u);
        const unsigned gen = old / nloc;
        if (old + 1u == (gen + 1u) * nloc) {
            __builtin_amdgcn_fence(__ATOMIC_RELEASE, "agent");
            asm volatile("s_waitcnt vmcnt(0)" ::: "memory");
            const unsigned og = xb_add(&bar[XB_TOP], 1u);
            const unsigned tg = og / nx;
            if (og + 1u == (tg + 1u) * nx) xb_add(&bar[XB_TOPGEN], 1u);
            else XB_SPIN(xb_ld(&bar[XB_TOPGEN]) == tg, bar);
            __builtin_amdgcn_fence(__ATOMIC_ACQUIRE, "agent");
            xb_add(&bar[XB_XGEN(b.x)], 1u);
            asm volatile("s_waitcnt vmcnt(0)" ::: "memory");
        } else {
            XB_SPIN(xb_ld(&bar[XB_XGEN(b.x)]) == gen, bar);
            __builtin_amdgcn_fence(__ATOMIC_ACQUIRE, "agent");
            asm volatile("s_waitcnt vmcnt(0)" ::: "memory");
        }
    }
    __syncthreads();
}

__global__ void __launch_bounds__(512, 2) fwd_kernel(Args a) {
    extern __shared__ __attribute__((aligned(16))) unsigned char lds_raw[];
    LAS unsigned char* lds = (LAS unsigned char*)lds_raw;
    cg::grid_group grid = cg::this_grid();
    const int wave = __builtin_amdgcn_readfirstlane((int)threadIdx.x >> 6), lane = lane_id(), tid = wave * 64 + lane;
    unsigned char* ws = a.ws;
    bf16* HN = (bf16*)(ws + WS_HN); bf16* Y = (bf16*)(ws + WS_Y); bf16* R1 = (bf16*)(ws + WS_R1); bf16* R1B = (bf16*)(ws + WS_R1B);
    float* STATS = (float*)(ws + WS_STATS);
#define GEMM_STEP(BANK, Aptr, Bptr, NN, KK, MODE, OUT0, OUT1) GEMM_STEP_M(BANK, MP, Aptr, Bptr, NN, KK, MODE, OUT0, OUT1)
#define GEMM_STEP_M(BANK, MROWS, Aptr, Bptr, NN, KK, MODE, OUT0, OUT1) do { pg8::Gemm g; g.A = (Aptr); g.Bt = (Bptr); g.M = (MROWS); g.N = (NN); g.K = (KK); g.lda = (KK); g.ldb = (KK); g.kmode = 0; g.ksl = 1; \
        EpiGen E; E.mode = (MODE); E.O0 = (OUT0); E.O1 = (OUT1); E.stats = STATS; E.XC = nullptr; E.pa = nullptr; E.pb = nullptr; E.pl = nullptr; E.ksl = 1; \
        PubOrder S; S.init((MROWS), (NN), (int)gridDim.x, (int)blockIdx.x, (BANK) == 7 ? 8 : 1); S.cnt = ctl + CW_CNT + (BANK) * CW_BANK; \
        if ((BANK) == 7) pg8::gemm_phase<EpiGen, pg8::StaticOrder, true, true>(lds, g, S, E, wave); else pg8::gemm_phase<EpiGen, PubOrder, true, true>(lds, g, S, E, wave); } while (0)
    volatile LAS unsigned* st = (volatile LAS unsigned*)(lds + 131072 + 64);
    if (tid < 2) st[tid] = 0u;
    unsigned* barw = (unsigned*)ws;
    unsigned* ctl = (unsigned*)ws;
    volatile LAS unsigned* bc = (volatile LAS unsigned*)(lds + 131072 + 128);
#define GU_STEP(RBANK, Bptr, GREADY, GNEED) do { pg8::Gemm g; g.A = HN; g.Bt = (Bptr); g.M = MP; g.N = 5632; g.K = 1024; g.lda = 1024; g.ldb = 1024; g.kmode = 0; g.ksl = 1; \
        EpiGen E; E.mode = 1; E.O0 = R1; E.O1 = nullptr; E.stats = STATS; E.XC = nullptr; E.pa = nullptr; E.pb = nullptr; E.pl = nullptr; E.ksl = 1; \
        CountedOrder S; S.init(MP, 5632, (int)gridDim.x, (int)blockIdx.x, 4); S.ready = ctl + CW_CNT + (RBANK) * CW_BANK; S.need = 8u; S.need66 = 4u; S.gready = (GREADY); S.gneed = (GNEED); S.wv = wave; S.gcnt = nullptr; S.cnt = ctl + CW_CNT + 7 * CW_BANK; \
        pg8::gemm_phase<EpiGen, CountedOrder, true, true>(lds, g, S, E, wave); } while (0)

#define DOWNM_STEP(BANK, Bptr, GUNEED, GCNT) do { pg8::Gemm g; g.A = R1; g.Bt = (Bptr); g.M = MAINR; g.N = 1024; g.K = DFF; g.lda = DFF; g.ldb = DFF; g.kmode = 0; g.ksl = 1; \
        EpiGen E; E.mode = 3; E.O0 = Y; E.O1 = nullptr; E.stats = STATS; E.XC = nullptr; E.pa = nullptr; E.pb = nullptr; E.pl = nullptr; E.ksl = 1; \
        CountedOrder S; S.init(MAINR, 1024, (int)gridDim.x, (int)blockIdx.x, 1); S.ready = ctl + CW_CNT + 7 * CW_BANK; S.need = (GUNEED); S.need66 = (GUNEED); S.gready = nullptr; S.gneed = 0u; S.wv = wave; S.gcnt = (GCNT); S.cnt = ctl + CW_CNT + (BANK) * CW_BANK; \
        pg8::gemm_phase<EpiGen, CountedOrder, true, true>(lds, g, S, E, wave); } while (0)
#define DOWNX_STEP(BANK, Bptr, GUNEED, GCNT) do { int kx_ = 256; asm volatile("" : "+s"(kx_)); \
        pg8::Gemm g; g.A = R1; g.Bt = (Bptr); g.M = MP; g.N = 1024; g.K = kx_; g.lda = DFF; g.ldb = DFF; g.kmode = 2; g.ksl = 11; \
        EpiGen E; E.mode = 5; E.O0 = Y; E.O1 = (bf16*)(ws + WS_Y2); E.stats = STATS; E.XC = nullptr; E.pa = nullptr; E.pb = nullptr; E.pl = nullptr; E.ksl = 11; \
        ExtraOrderC S; S.init(MP, 1024, (int)gridDim.x, (int)blockIdx.x, 1); S.ready = ctl + CW_CNT + 7 * CW_BANK; S.need = (GUNEED); S.need66 = (GUNEED); S.gready = nullptr; S.gneed = 0u; S.wv = wave; S.gcnt = (GCNT); S.cnt = ctl + CW_CNT + (BANK) * CW_BANK; S.ksl = 11; \
        pg8::gemm_phase<EpiGen, ExtraOrderC, true, true>(lds, g, S, E, wave); } while (0)
#define OUT_STEP(BANK, Bptr, RBANK, NEEDP, NEED66P) do { { pg8::Gemm g; g.A = HN; g.Bt = (Bptr); g.M = MAINR; g.N = 1024; g.K = 1024; g.lda = 1024; g.ldb = 1024; g.kmode = 0; g.ksl = 1; \
        EpiGen E; E.mode = 3; E.O0 = Y; E.O1 = nullptr; E.stats = STATS; E.XC = nullptr; E.pa = nullptr; E.pb = nullptr; E.pl = nullptr; E.ksl = 1; \
        CountedOrder S; S.init(MAINR, 1024, (int)gridDim.x, (int)blockIdx.x, 1); S.ready = ctl + CW_CNT + (RBANK) * CW_BANK; S.need = (NEEDP); S.need66 = (NEED66P); S.gready = nullptr; S.gneed = 0u; S.wv = wave; S.gcnt = nullptr; S.cnt = ctl + CW_CNT + (BANK) * CW_BANK; \
        pg8::gemm_phase<EpiGen, CountedOrder, true, true>(lds, g, S, E, wave); } \
      { int kx_ = 256; asm volatile("" : "+s"(kx_)); \
        pg8::Gemm g; g.A = HN; g.Bt = (Bptr); g.M = MP; g.N = 1024; g.K = kx_; g.lda = 1024; g.ldb = 1024; g.kmode = 2; g.ksl = 4; \
        EpiGen E; E.mode = 5; E.O0 = Y; E.O1 = (bf16*)(ws + WS_Y2); E.stats = STATS; E.XC = nullptr; E.pa = nullptr; E.pb = nullptr; E.pl = nullptr; E.ksl = 4; \
        ExtraOrderC S; S.init(MP, 1024, (int)gridDim.x, (int)blockIdx.x, 1); S.ready = ctl + CW_CNT + (RBANK) * CW_BANK; S.need = (NEEDP); S.need66 = (NEED66P); S.gready = nullptr; S.gneed = 0u; S.wv = wave; S.gcnt = nullptr; S.cnt = ctl + CW_CNT + (BANK) * CW_BANK; S.ksl = 4; \
        pg8::gemm_phase<EpiGen, ExtraOrderC, true, true>(lds, g, S, E, wave); } } while (0)
#define EXTRA_STEP(BANK, Aptr, Bptr, KTOT, NSL) do { int kx_ = 256; asm volatile("" : "+s"(kx_));     \
        pg8::Gemm g; g.A = (Aptr); g.Bt = (Bptr); g.M = MP; g.N = 1024; g.K = kx_; g.lda = (KTOT); g.ldb = (KTOT); g.kmode = 2; g.ksl = (NSL); \
        EpiGen E; E.mode = 5; E.O0 = Y; E.O1 = (bf16*)(ws + WS_Y2); E.stats = STATS; E.XC = nullptr; E.pa = nullptr; E.pb = nullptr; E.pl = nullptr; E.ksl = (NSL); \
        ExtraOrder S; S.init(MP, 1024, (int)gridDim.x, (int)blockIdx.x, 1); S.cnt = ctl + CW_CNT + (BANK) * CW_BANK; S.ksl = (NSL); \
        pg8::gemm_phase<EpiGen, ExtraOrder, true, true>(lds, g, S, E, wave); } while (0)
    __syncthreads();
    XcdBarrier bar = xcd_barrier_post(barw, st, wave);
#define GSYNC() xcd_barrier(bar, wave)
    if (a.ws == nullptr) grid.sync();
    p0_phase(a, lds, wave, lane); GSYNC();
    GEMM_STEP(0, HN, (const bf16*)(ws + WS_WIN0), 2048, 1024, 0, R1, R1B);
    rgconv_tail(a, ctl, bc, wave); p0b_tail(a, lds, wave, lane, ctl, bc); GSYNC();
    { pg8::Gemm g; g.A = HN; g.Bt = (const bf16*)(ws + WS_WG); g.M = MP; g.N = 2048; g.K = 256; g.lda = 1024; g.ldb = 256; g.kmode = 1; g.ksl = 1;
      EpiGen E; E.mode = 4; E.O0 = Y; E.O1 = R1B; E.stats = STATS; E.ksl = 1; E.XC = HN; E.pa = a.in[14]; E.pb = a.in[16]; E.pl = a.in[17];
      PubOrder S; S.init(MP, 2048, (int)gridDim.x, (int)blockIdx.x, 1); S.cnt = ctl + CW_CNT + 1 * CW_BANK;
      pg8::gemm_phase<EpiGen, PubOrder, true, true>(lds, g, S, E, wave); }
    lru_scan1_tail(a, lds, ctl, bc, wave);
    lru_scan2_phase(a, lds, wave, ctl);
    OUT_STEP(2, (const bf16*)(ws + WS_WOUT0), 12, 16u, 8u);
    norm_res_tail<true, 4, 8>(a, a.in[7], a.in[8], wave, lane, ctl, 2, bc);
    GU_STEP(8, (const bf16*)(ws + WS_WGU), ctl + CW_CNT + 12 * CW_BANK + 64 * 100, 1064u);
    DOWNM_STEP(3, (const bf16*)(ws + WS_WD), 176u, ctl + CW_CNT + 3 * CW_BANK + 64 * 100); DOWNX_STEP(3, (const bf16*)(ws + WS_WD), 176u, ctl + CW_CNT + 3 * CW_BANK + 64 * 100);
    norm_res_tail<false, 11, 11>(a, a.in[9], a.in[6] + D, wave, lane, ctl, 3, bc);
    { pg8::Gemm g; g.A = HN; g.Bt = (const bf16*)(ws + WS_WSCIN); g.M = MP; g.N = 3072; g.K = 1024; g.lda = 1024; g.ldb = 1024; g.kmode = 0; g.ksl = 1;
      EpiGen E; E.mode = 2; E.O0 = R1; E.O1 = R1B; E.stats = STATS; E.XC = nullptr; E.pa = nullptr; E.pb = nullptr; E.pl = nullptr; E.ksl = 1;
      CountedOrder S; S.init(MP, 3072, (int)gridDim.x, (int)blockIdx.x, 1); S.ready = ctl + CW_CNT + 11 * CW_BANK; S.need = 8u; S.need66 = 4u;
      S.gready = ctl + CW_CNT + 3 * CW_BANK + 64 * 100; S.gneed = (256u + 132u) * 8u;
      S.wv = wave; S.gcnt = nullptr; S.cnt = ctl + CW_CNT + 4 * CW_BANK;
      pg8::gemm_phase<EpiGen, CountedOrder, true, true>(lds, g, S, E, wave); }
    sconv_tail(a, ctl, bc, wave);
    OUT_STEP(5, (const bf16*)(ws + WS_WSCOUT), 10, 8u, 4u);
    norm_res_tail<false, 4, 9>(a, a.in[7] + D, a.in[8] + D, wave, lane, ctl, 5, bc);
    GU_STEP(9, (const bf16*)(ws + WS_WGU) + (size_t)5632 * 1024, ctl + CW_CNT + 10 * CW_BANK + 64 * 100, 532u);
    DOWNM_STEP(6, (const bf16*)(ws + WS_WD) + (size_t)1024 * DFF, 352u, nullptr); DOWNX_STEP(6, (const bf16*)(ws + WS_WD) + (size_t)1024 * DFF, 352u, nullptr);
    norm_res_tail<false, 11, -1>(a, a.in[9] + D, nullptr, wave, lane, ctl, 6, bc);
}

extern "C" void kernel_launch(void* const* d_in, const int* in_sizes, int n_in, void* d_out, int out_size, void* d_ws, size_t ws_size, hipStream_t stream) {
    static int grid = 0;
    if (grid == 0) {
        if (n_in != 25 || ws_size < WS_END) { fprintf(stderr, "kernel_launch: unexpected n_in %d / ws_size %zu\n", n_in, ws_size); grid = -1; return; }
        int dev = 0, cus = 0, per_cu = 0;
        hipGetDevice(&dev);
        hipDeviceGetAttribute(&cus, hipDeviceAttributeMultiprocessorCount, dev);
        if (hipFuncSetAttribute((const void*)fwd_kernel, hipFuncAttributeMaxDynamicSharedMemorySize, LDS_BYTES) != hipSuccess) { fprintf(stderr, "kernel_launch: hipFuncSetAttribute failed\n"); grid = -1; return; }
        if (hipOccupancyMaxActiveBlocksPerMultiprocessor(&per_cu, (const void*)fwd_kernel, 512, LDS_BYTES) != hipSuccess || per_cu < 1) { fprintf(stderr, "kernel_launch: occupancy query failed (%d)\n", per_cu); (void)hipGetLastError(); per_cu = 1; }
        grid = cus * per_cu;
        fprintf(stderr, "kernel_launch: %d CUs x %d = grid %d\n", cus, per_cu, grid);
    }
    if (grid < 0) return;
    Args a{};
    for (int i = 0; i < 25; ++i) a.in[i] = (const float*)d_in[i];
    a.out = (float*)d_out; a.ws = (unsigned char*)d_ws;
    if (hipMemsetAsync(d_ws, 0, (size_t)CTL_WORDS * 4, stream) != hipSuccess) { fprintf(stderr, "kernel_launch: memset failed\n"); return; }
    void* args[] = {&a};
    hipError_t e = hipLaunchCooperativeKernel((const void*)fwd_kernel, dim3(grid), dim3(512), args, LDS_BYTES, stream);
    if (e != hipSuccess) fprintf(stderr, "kernel_launch: cooperative launch failed: %s (grid %d)\n", hipGetErrorString(e), grid);
}
```
